# Optimizing an MI355X kernel written in HIP

```python
import math
import jax, jax.numpy as jnp
from jax import lax
import numpy as np

D_MODEL = 1024
BATCH = 8
SEQ = 2048
DEPTH = 2

GRID_W = 64
CTX_LEN = 256
HEAD_DIM = 64
BLOCK = 128
A_Q_HEADS = 8
A_KV_HEADS = 2
WINDOW = 128
B_HEADS = 4
B_V_DIM = 2 * HEAD_DIM
A_Q_W = A_Q_HEADS * HEAD_DIM
A_KV_W = A_KV_HEADS * HEAD_DIM
B_QK_W = B_HEADS * 2 * HEAD_DIM
B_V_W = B_HEADS * B_V_DIM
ATTN_IN = A_Q_W + 2 * A_KV_W + 2 * B_QK_W + B_V_W
ATTN_OUT = A_Q_W + B_V_W
S5_WIDTH = D_MODEL
S5_GROUP = 16
S5_GROUPS = S5_WIDTH // S5_GROUP
S5_STATE = 64
D_FF = 4 * D_MODEL
ROPE_BASE = 10000.0
EPS = 1e-6
NEG_INF = -1e30
F32 = jnp.float32

kernel_name = "hybrid_prefix_dit_swa_diff_s5"


def rms_norm(x, g):
    xf = x.astype(F32)
    y = xf * lax.rsqrt(jnp.mean(xf * xf, axis=-1, keepdims=True) + EPS)
    return (y * g.astype(F32)).astype(x.dtype)


def axial_rope_tables(rows_n):
    row = jnp.repeat(jnp.arange(rows_n, dtype=F32), GRID_W)
    col = jnp.tile(jnp.arange(GRID_W, dtype=F32), rows_n)
    n_freq = HEAD_DIM // 4
    inv = ROPE_BASE ** (-jnp.arange(n_freq, dtype=F32) / n_freq)
    ang = jnp.concatenate([row[:, None] * inv, col[:, None] * inv], axis=-1)
    return jnp.cos(ang), jnp.sin(ang)


def apply_rope(x, cos, sin):
    shape = (cos.shape[0],) + (1,) * (x.ndim - 3) + (cos.shape[1],)
    cs = cos.reshape(shape).astype(x.dtype)
    sn = sin.reshape(shape).astype(x.dtype)
    x1, x2 = jnp.split(x, 2, axis=-1)
    return jnp.concatenate([x1 * cs - x2 * sn, x2 * cs + x1 * sn], axis=-1)


def split_attn_proj(z):
    bn, t, _ = z.shape
    cuts = np.cumsum([A_Q_W, A_KV_W, A_KV_W, B_QK_W, B_QK_W]).tolist()
    qa, ka, va, qb, kb, vb = jnp.split(z, cuts, axis=-1)
    return (qa.reshape(bn, t, A_Q_HEADS, HEAD_DIM),
            ka.reshape(bn, t, A_KV_HEADS, HEAD_DIM),
            va.reshape(bn, t, A_KV_HEADS, HEAD_DIM),
            qb.reshape(bn, t, B_HEADS, 2, HEAD_DIM),
            kb.reshape(bn, t, B_HEADS, 2, HEAD_DIM),
            vb.reshape(bn, t, B_HEADS, B_V_DIM))


def window_attention(q, k, v, kc, vc, sink):
    bn, L, hq, d = q.shape
    hkv = k.shape[2]
    g = hq // hkv
    nb = L // BLOCK
    scale = d ** -0.5
    qb = q.reshape(bn, nb, BLOCK, hkv, g, d)
    pad = ((0, 0), (BLOCK, BLOCK), (0, 0), (0, 0))
    kp = jnp.pad(k, pad).reshape(bn, nb + 2, BLOCK, hkv, d)
    vp = jnp.pad(v, pad).reshape(bn, nb + 2, BLOCK, hkv, d)
    kw = jnp.concatenate([kp[:, :-2], kp[:, 1:-1], kp[:, 2:]], axis=2)
    vw = jnp.concatenate([vp[:, :-2], vp[:, 1:-1], vp[:, 2:]], axis=2)
    s_win = jnp.einsum('bnqhgd,bnkhd->bnhgqk', qb, kw).astype(F32) * scale
    qi = jnp.arange(BLOCK)[:, None]
    kj = jnp.arange(3 * BLOCK)[None, :]
    jpos = jnp.arange(nb)[:, None, None] * BLOCK + kj[None] - BLOCK
    valid = (jnp.abs(kj - BLOCK - qi) <= WINDOW)[None] & (jpos >= 0) & (jpos < L)
    s_win = jnp.where(valid[None, :, None, None], s_win, NEG_INF)
    s_ctx = jnp.einsum('bnqhgd,bkhd->bnhgqk', qb, kc).astype(F32) * scale
    s_sink = jnp.broadcast_to(sink.astype(F32).reshape(1, 1, hkv, g, 1, 1), s_win.shape[:-1] + (1,))
    p = jax.nn.softmax(jnp.concatenate([s_win, s_ctx, s_sink], axis=-1), axis=-1).astype(v.dtype)
    nw = 3 * BLOCK
    nc = kc.shape[1]
    o = (jnp.einsum('bnhgqk,bnkhd->bnqhgd', p[..., :nw], vw)
         + jnp.einsum('bnhgqk,bkhd->bnqhgd', p[..., nw:nw + nc], vc))
    return o.reshape(bn, L, hq * d)


def gqa_sink_dense(q, k, v, sink):
    bn, t, hq, d = q.shape
    hkv = k.shape[2]
    g = hq // hkv
    qg = q.reshape(bn, t, hkv, g, d)
    s = jnp.einsum('bqhgd,bkhd->bhgqk', qg, k).astype(F32) * d ** -0.5
    sk = jnp.broadcast_to(sink.astype(F32).reshape(1, hkv, g, 1, 1), s.shape[:-1] + (1,))
    p = jax.nn.softmax(jnp.concatenate([s, sk], axis=-1), axis=-1)[..., :-1].astype(v.dtype)
    o = jnp.einsum('bhgqk,bkhd->bqhgd', p, v)
    return o.reshape(bn, t, hq * d)


def diff_attend(q, k, v, lam):
    s = jnp.einsum('bqhmd,bkhmd->bhmqk', q, k).astype(F32) * HEAD_DIM ** -0.5
    p = jax.nn.softmax(s, axis=-1)
    w = p[:, :, 0] - lam * p[:, :, 1]
    return jnp.einsum('bhqk,bkhe->bqhe', w.astype(v.dtype), v)


def diff_attention_latent(q, k, v, kc, vc, lam):
    bn, L, h, _, d = q.shape
    nb = L // BLOCK
    k_all = jnp.concatenate([kc, k], axis=1)
    v_all = jnp.concatenate([vc, v], axis=1)
    qb = jnp.moveaxis(q.reshape(bn, nb, BLOCK, h, 2, d), 1, 0)
    o = lax.map(lambda qblk: diff_attend(qblk, k_all, v_all, lam), qb)
    return jnp.moveaxis(o, 0, 1).reshape(bn, L, h, v.shape[-1])


def attn_mixer(h_lat, h_ctx, w_in, w_out, a_qn, a_kn, a_sink, b_qn, b_kn, lq1, lk1, lq2, lk2, subln,
               cos, sin, lambda_init, need_ctx):
    qa, ka, va, qb, kb, vb = split_attn_proj(h_lat @ w_in)
    qa_c, ka_c, va_c, qb_c, kb_c, vb_c = split_attn_proj(h_ctx @ w_in)
    qa = apply_rope(rms_norm(qa, a_qn), cos, sin)
    ka = apply_rope(rms_norm(ka, a_kn), cos, sin)
    qb = apply_rope(rms_norm(qb, b_qn), cos, sin)
    kb = apply_rope(rms_norm(kb, b_kn), cos, sin)
    ka_c = rms_norm(ka_c, a_kn)
    kb_c = rms_norm(kb_c, b_kn)
    lam = (jnp.exp(jnp.sum(lq1.astype(F32) * lk1.astype(F32)))
           - jnp.exp(jnp.sum(lq2.astype(F32) * lk2.astype(F32))) + lambda_init)

    def merge(ya, yb):
        yb = rms_norm(yb, subln) * (1.0 - lambda_init)
        yb = yb.reshape(yb.shape[0], yb.shape[1], B_V_W)
        return jnp.concatenate([ya, yb], axis=-1) @ w_out

    y_lat = merge(window_attention(qa, ka, va, ka_c, va_c, a_sink),
                  diff_attention_latent(qb, kb, vb, kb_c, vb_c, lam))
    y_ctx = None
    if need_ctx:
        qa_c = rms_norm(qa_c, a_qn)
        qb_c = rms_norm(qb_c, b_qn)
        y_ctx = merge(gqa_sink_dense(qa_c, ka_c, va_c, a_sink), diff_attend(qb_c, kb_c, vb_c, lam))
    return y_lat, y_ctx


def s5_discretize(lam_re, lam_im, log_step, b_re, b_im):
    lam_re = lam_re.astype(F32)
    lam_im = lam_im.astype(F32)
    b_re = b_re.astype(F32)
    b_im = b_im.astype(F32)
    dt = jnp.exp(log_step.astype(F32))[:, None]
    mag = jnp.exp(lam_re * dt)
    ab_re = mag * jnp.cos(lam_im * dt)
    ab_im = mag * jnp.sin(lam_im * dt)
    den = lam_re * lam_re + lam_im * lam_im
    nr = ab_re - 1.0
    f_re = (nr * lam_re + ab_im * lam_im) / den
    f_im = (ab_im * lam_re - nr * lam_im) / den
    bb_re = f_re[..., None] * b_re - f_im[..., None] * b_im
    bb_im = f_re[..., None] * b_im + f_im[..., None] * b_re
    return ab_re, ab_im, bb_re, bb_im


def _cplx_combine(e1, e2):
    a1r, a1i, b1r, b1i = e1
    a2r, a2i, b2r, b2i = e2
    return (a2r * a1r - a2i * a1i,
            a2r * a1i + a2i * a1r,
            a2r * b1r - a2i * b1i + b2r,
            a2r * b1i + a2i * b1r + b2i)


def s5_scan(u, ab_re, ab_im, bb_re, bb_im, h0, reverse):
    t = u.shape[1]
    bu_re = jnp.einsum('btgh,gph->btgp', u, bb_re)
    bu_im = jnp.einsum('btgh,gph->btgp', u, bb_im)
    if h0 is not None:
        h0_re, h0_im = h0
        t0 = t - 1 if reverse else 0
        bu_re = bu_re.at[:, t0].add(ab_re * h0_re - ab_im * h0_im)
        bu_im = bu_im.at[:, t0].add(ab_re * h0_im + ab_im * h0_re)
    a_re = jnp.broadcast_to(ab_re[None, None], (1, t) + ab_re.shape)
    a_im = jnp.broadcast_to(ab_im[None, None], (1, t) + ab_im.shape)
    _, _, h_re, h_im = lax.associative_scan(_cplx_combine, (a_re, a_im, bu_re, bu_im), reverse=reverse, axis=1)
    return h_re, h_im


def s5_readout(h_re, h_im, c_re, c_im):
    return jnp.einsum('btgp,ghp->btgh', h_re, c_re) - jnp.einsum('btgp,ghp->btgh', h_im, c_im)


def s5_mixer(h_lat, h_ctx, w_in, lam_re, lam_im, log_step, b_re, b_im, c_re, c_im, d_skip, glu_w, glu_b, w_out,
             need_ctx):
    bn, L, _ = h_lat.shape
    nc = h_ctx.shape[1]
    u_lat = (h_lat @ w_in).astype(F32)
    u_ctx = (h_ctx @ w_in).astype(F32)
    ul = u_lat.reshape(bn, L, S5_GROUPS, S5_GROUP)
    uc = u_ctx.reshape(bn, nc, S5_GROUPS, S5_GROUP)
    dsk = d_skip.astype(F32)
    y_lat = u_lat * dsk
    y_ctx = u_ctx * dsk if need_ctx else None
    for direction in range(2):
        reverse = direction == 1
        ab_re, ab_im, bb_re, bb_im = s5_discretize(lam_re[direction], lam_im[direction], log_step[direction],
                                                   b_re[direction], b_im[direction])
        cr = c_re[direction].astype(F32)
        ci = c_im[direction].astype(F32)
        hc_re, hc_im = s5_scan(uc, ab_re, ab_im, bb_re, bb_im, None, reverse)
        t_end = 0 if reverse else nc - 1
        hl_re, hl_im = s5_scan(ul, ab_re, ab_im, bb_re, bb_im, (hc_re[:, t_end], hc_im[:, t_end]), reverse)
        y_lat = y_lat + s5_readout(hl_re, hl_im, cr, ci).reshape(bn, L, S5_WIDTH)
        if need_ctx:
            y_ctx = y_ctx + s5_readout(hc_re, hc_im, cr, ci).reshape(bn, nc, S5_WIDTH)

    def out_map(y):
        g = jax.nn.gelu(y).astype(h_lat.dtype)
        g = g * jax.nn.sigmoid(g @ glu_w + glu_b)
        return g @ w_out

    return out_map(y_lat), (out_map(y_ctx) if need_ctx else None)


def sq_relu_mlp(h, w1, w2):
    return jnp.square(jax.nn.relu(h @ w1)) @ w2


def setup_inputs(seed: int = 0) -> dict:
    key = jax.random.key(seed)
    ks = iter(jax.random.split(key, 40))
    n_attn = (DEPTH + 1) // 2
    n_ssm = DEPTH // 2

    def nrm(shape, scale):
        return scale * jax.random.normal(next(ks), shape, F32)

    def gain(shape):
        return 1.0 + nrm(shape, 0.02)

    n_idx = jnp.arange(S5_STATE, dtype=F32)
    s5_state_shape = (n_ssm, 2, S5_GROUPS, S5_STATE)
    return {
        "x": nrm((BATCH, SEQ, D_MODEL), 1.0),
        "c": nrm((BATCH, D_MODEL), 1.0),
        "ctx": nrm((BATCH, CTX_LEN, D_MODEL), 1.0),
        "c_ctx": nrm((D_MODEL,), 1.0),
        "norm1_g": gain((DEPTH, D_MODEL)),
        "norm2_g": gain((DEPTH, D_MODEL)),
        "mod_w": nrm((DEPTH, D_MODEL, 6 * D_MODEL), 0.5 * D_MODEL ** -0.5),
        "mod_b": nrm((DEPTH, 6 * D_MODEL), 0.02),
        "mlp_w1": nrm((DEPTH, D_MODEL, D_FF), D_MODEL ** -0.5),
        "mlp_w2": nrm((DEPTH, D_FF, D_MODEL), D_FF ** -0.5),
        "attn_w_in": nrm((n_attn, D_MODEL, ATTN_IN), D_MODEL ** -0.5),
        "attn_w_out": nrm((n_attn, ATTN_OUT, D_MODEL), ATTN_OUT ** -0.5),
        "a_q_norm": gain((n_attn, HEAD_DIM)),
        "a_k_norm": gain((n_attn, HEAD_DIM)),
        "a_sink": nrm((n_attn, A_Q_HEADS), 0.5),
        "b_q_norm": gain((n_attn, HEAD_DIM)),
        "b_k_norm": gain((n_attn, HEAD_DIM)),
        "b_lq1": nrm((n_attn, HEAD_DIM), 0.1),
        "b_lk1": nrm((n_attn, HEAD_DIM), 0.1),
        "b_lq2": nrm((n_attn, HEAD_DIM), 0.1),
        "b_lk2": nrm((n_attn, HEAD_DIM), 0.1),
        "b_subln": gain((n_attn, B_V_DIM)),
        "s5_w_in": nrm((n_ssm, D_MODEL, S5_WIDTH), D_MODEL ** -0.5),
        "s5_lambda_re": -0.5 + nrm(s5_state_shape, 0.01),
        "s5_lambda_im": jnp.pi * n_idx + nrm(s5_state_shape, 0.01),
        "s5_log_step": jax.random.uniform(next(ks), (n_ssm, 2, S5_GROUPS), dtype=F32,
                                          minval=math.log(1e-3), maxval=math.log(1e-1)),
        "s5_b_re": nrm((n_ssm, 2, S5_GROUPS, S5_STATE, S5_GROUP), (2 * S5_GROUP) ** -0.5),
        "s5_b_im": nrm((n_ssm, 2, S5_GROUPS, S5_STATE, S5_GROUP), (2 * S5_GROUP) ** -0.5),
        "s5_c_re": nrm((n_ssm, 2, S5_GROUPS, S5_GROUP, S5_STATE), (2 * S5_STATE) ** -0.5),
        "s5_c_im": nrm((n_ssm, 2, S5_GROUPS, S5_GROUP, S5_STATE), (2 * S5_STATE) ** -0.5),
        "s5_d": nrm((n_ssm, S5_WIDTH), 1.0),
        "s5_glu_w": nrm((n_ssm, S5_WIDTH, S5_WIDTH), S5_WIDTH ** -0.5),
        "s5_glu_b": nrm((n_ssm, S5_WIDTH), 0.02),
        "s5_w_out": nrm((n_ssm, S5_WIDTH, D_MODEL), S5_WIDTH ** -0.5),
    }


def reference(x, c, ctx, c_ctx, norm1_g, norm2_g, mod_w, mod_b, mlp_w1, mlp_w2, attn_w_in, attn_w_out,
              a_q_norm, a_k_norm, a_sink, b_q_norm, b_k_norm, b_lq1, b_lk1, b_lq2, b_lk2, b_subln,
              s5_w_in, s5_lambda_re, s5_lambda_im, s5_log_step, s5_b_re, s5_b_im, s5_c_re, s5_c_im, s5_d,
              s5_glu_w, s5_glu_b, s5_w_out):
    bn, L, _ = x.shape
    ROWS = L // GRID_W
    cos, sin = axial_rope_tables(ROWS)
    s_lat = jax.nn.silu(c)
    s_ctx = jax.nn.silu(c_ctx)
    h_lat, h_ctx = x, ctx
    for i in range(DEPTH):
        last = i == DEPTH - 1
        j = i // 2
        m_lat = jnp.split((s_lat @ mod_w[i] + mod_b[i])[:, None, :], 6, axis=-1)
        m_ctx = jnp.split((s_ctx @ mod_w[i] + mod_b[i])[None, None, :], 6, axis=-1)
        a_lat = rms_norm(h_lat, norm1_g[i]) * (1.0 + m_lat[1]) + m_lat[0]
        a_ctx = rms_norm(h_ctx, norm1_g[i]) * (1.0 + m_ctx[1]) + m_ctx[0]
        if i % 2 == 0:
            lambda_init = 0.8 - 0.6 * math.exp(-0.3 * i)
            y_lat, y_ctx = attn_mixer(a_lat, a_ctx, attn_w_in[j], attn_w_out[j], a_q_norm[j], a_k_norm[j],
                                      a_sink[j], b_q_norm[j], b_k_norm[j], b_lq1[j], b_lk1[j], b_lq2[j],
                                      b_lk2[j], b_subln[j], cos, sin, lambda_init, not last)
        else:
            y_lat, y_ctx = s5_mixer(a_lat, a_ctx, s5_w_in[j], s5_lambda_re[j], s5_lambda_im[j], s5_log_step[j],
                                    s5_b_re[j], s5_b_im[j], s5_c_re[j], s5_c_im[j], s5_d[j], s5_glu_w[j],
                                    s5_glu_b[j], s5_w_out[j], not last)
        h_lat = h_lat + m_lat[2] * y_lat
        f_lat = rms_norm(h_lat, norm2_g[i]) * (1.0 + m_lat[4]) + m_lat[3]
        h_lat = h_lat + m_lat[5] * sq_relu_mlp(f_lat, mlp_w1[i], mlp_w2[i])
        if not last:
            h_ctx = h_ctx + m_ctx[2] * y_ctx
            f_ctx = rms_norm(h_ctx, norm2_g[i]) * (1.0 + m_ctx[4]) + m_ctx[3]
            h_ctx = h_ctx + m_ctx[5] * sq_relu_mlp(f_ctx, mlp_w1[i], mlp_w2[i])
    return h_lat
```

```cpp
#include <hip/hip_runtime.h>
#include <cstdint>
#include <cstdio>

namespace cfg {
constexpr int D = 1024, B = 8, L = 2048, NC = 256, FF = 4096;
constexpr int ML = B * L, MC = B * NC, M = ML + MC;
constexpr int ZW = 2304;
constexpr int ZQA = 0, ZKA = 512, ZVA = 640, ZQB = 768, ZKB = 1280, ZVB = 1792;
constexpr float EPS = 1e-6f;
constexpr float C2 = 0.125f * 1.4426950408889634f;
constexpr float LOG2E = 1.4426950408889634f;
constexpr float LAMBDA_INIT0 = 0.2f;
constexpr size_t MiB = 1u << 20;
constexpr size_t WS_CTL = 0;
constexpr size_t WS_MODV = 1 * MiB;
constexpr size_t WS_ROPE = 1 * MiB + 512 * 1024;
constexpr size_t WS_S5AB = 2 * MiB;
constexpr size_t WS_LAM = 2 * MiB + 64 * 1024;
constexpr size_t WS_S5BB = 3 * MiB;
constexpr size_t WS_HCTX = 56 * MiB;
constexpr size_t WS_A = 64 * MiB;
constexpr size_t WS_Z = 100 * MiB;
constexpr size_t WS_O = 181 * MiB;
constexpr size_t WS_U1 = 100 * MiB;
constexpr size_t WS_U = 100 * MiB;
constexpr size_t WS_YT = 136 * MiB;
constexpr size_t WS_G = 200 * MiB;
constexpr size_t WS_G2 = 64 * MiB;
}
using namespace cfg;

typedef unsigned short bf16_t;
__device__ __forceinline__ bf16_t f2bf(float f) { unsigned u = __builtin_bit_cast(unsigned, f); return (bf16_t)((u + 0x7fffu + ((u >> 16) & 1u)) >> 16); }
__device__ __forceinline__ float bf2f(bf16_t h) { return __builtin_bit_cast(float, (unsigned)h << 16); }
__device__ __forceinline__ float bfr(float f) { return bf2f(f2bf(f)); }
__device__ __forceinline__ float silu(float x) { return x / (1.f + expf(-x)); }

namespace nv {
__global__ void mod_gemv(const float* c, const float* c_ctx, const float* mod_w, const float* mod_b, float* modv) {
    const int n = blockIdx.x * 256 + threadIdx.x, l = blockIdx.y;
    __shared__ float s[9][1024];
    for (int i = threadIdx.x; i < 9 * 1024; i += 256) { const int r = i >> 10, k = i & 1023; s[r][k] = silu(r < 8 ? c[r * 1024 + k] : c_ctx[k]); }
    __syncthreads();
    float acc[9];
    for (int r = 0; r < 9; ++r) acc[r] = 0.f;
    const float* w = mod_w + (size_t)l * 1024 * 6144 + n;
    for (int k = 0; k < 1024; ++k) { const float wv = w[(size_t)k * 6144];
        for (int r = 0; r < 9; ++r) acc[r] += s[r][k] * wv; }
    for (int r = 0; r < 9; ++r) modv[((size_t)l * 9 + r) * 6144 + n] = acc[r] + mod_b[l * 6144 + n];
}
__global__ void rope_table(float* rope) {
    const int i = blockIdx.x * 256 + threadIdx.x; if (i >= 2048 * 32) return;
    const int t = i >> 5, k = i & 31; const int f = k & 15;
    const float inv = powf(10000.f, -(float)f / 16.f);
    const float pos = (k < 16) ? (float)(t >> 6) : (float)(t & 63);
    const float ang = pos * inv;
    rope[i] = cosf(ang); rope[2048 * 32 + i] = sinf(ang);
}
__global__ void s5_disc(const float* lam_re, const float* lam_im, const float* log_step, const float* b_re, const float* b_im, float* ab, float* bb) {
    const int i = blockIdx.x * 256 + threadIdx.x; if (i >= 2 * 64 * 64) return;
    const int dg = i >> 6;
    const float lr = lam_re[i], li = lam_im[i], dt = expf(log_step[dg]);
    const float mag = expf(lr * dt), ar = mag * cosf(li * dt), ai = mag * sinf(li * dt);
    const float den = lr * lr + li * li, nr = ar - 1.f;
    const float fr = (nr * lr + ai * li) / den, fi = (ai * lr - nr * li) / den;
    ab[2 * i] = ar; ab[2 * i + 1] = ai;
    for (int h = 0; h < 16; ++h) { const float br = b_re[(size_t)i * 16 + h], bi = b_im[(size_t)i * 16 + h];
        bb[(size_t)i * 16 + h] = fr * br - fi * bi; bb[(size_t)2 * 64 * 64 * 16 + (size_t)i * 16 + h] = fr * bi + fi * br; }
}
__global__ void lam_kernel(const float* lq1, const float* lk1, const float* lq2, const float* lk2, float* lam) {
    if (threadIdx.x == 0) { float s1 = 0.f, s2 = 0.f; for (int i = 0; i < 64; ++i) { s1 += lq1[i] * lk1[i]; s2 += lq2[i] * lk2[i]; } lam[0] = expf(s1) - expf(s2) + LAMBDA_INIT0; }
}
__global__ void norm_mod(const float* src_lat, const float* src_ctx, const float* g, const float* modv_l, int shift_idx, int scale_idx, bf16_t* out) {
    const int r = blockIdx.x, tid = threadIdx.x;
    const float* x = r < ML ? src_lat + (size_t)r * D : src_ctx + (size_t)(r - ML) * D;
    const int mr = r < ML ? (r >> 11) : 8;
    const float* mv = modv_l + (size_t)mr * 6144;
    float v[4]; float ss = 0.f;
    for (int j = 0; j < 4; ++j) { v[j] = x[tid + 256 * j]; ss += v[j] * v[j]; }
    __shared__ float red[256];
    red[tid] = ss; __syncthreads();
    for (int o = 128; o > 0; o >>= 1) { if (tid < o) red[tid] += red[tid + o]; __syncthreads(); }
    const float rstd = 1.f / sqrtf(red[0] / (float)D + EPS);
    for (int j = 0; j < 4; ++j) { const int col = tid + 256 * j;
        out[(size_t)r * D + col] = f2bf(v[j] * rstd * g[col] * (1.f + mv[scale_idx * 1024 + col]) + mv[shift_idx * 1024 + col]); }
}
struct Epi {
    bf16_t* obf; int ldo;
    const float* hin_lat; const float* hin_ctx; float* hout_lat; float* hout_ctx;
    const float* modv_l; int gate_idx;
    const bf16_t* gin; const float* bias;
};
enum { E_BF16 = 0, E_RELU2 = 1, E_RESID = 2, E_GLU = 3 };
template <int MODE> __device__ __forceinline__ void epi_store(const Epi& e, int row, int col, float acc) {
    if (MODE == E_BF16) e.obf[(size_t)row * e.ldo + col] = f2bf(acc);
    else if (MODE == E_RELU2) { const float r = acc > 0.f ? acc : 0.f; e.obf[(size_t)row * e.ldo + col] = f2bf(r * r); }
    else if (MODE == E_RESID) {
        if (row < ML) { const float gate = e.modv_l[(size_t)(row >> 11) * 6144 + e.gate_idx * 1024 + col]; e.hout_lat[(size_t)row * D + col] = e.hin_lat[(size_t)row * D + col] + gate * acc; }
        else { const float gate = e.modv_l[(size_t)8 * 6144 + e.gate_idx * 1024 + col]; const size_t o = (size_t)(row - ML) * D + col; e.hout_ctx[o] = e.hin_ctx[o] + gate * acc; }
    } else if (MODE == E_GLU) { const float gv = bf2f(e.gin[(size_t)row * D + col]); const float z = acc + e.bias[col]; e.obf[(size_t)row * e.ldo + col] = f2bf(gv / (1.f + expf(-z))); }
}
template <int MODE> __global__ void __launch_bounds__(256) gemm(const bf16_t* A, const float* W, int Mr, int N, int K, Epi e) {
    __shared__ float As[16][65]; __shared__ float Ws[16][65];
    const int tid = threadIdx.x, tx = tid & 15, ty = tid >> 4;
    const int m0 = blockIdx.y * 64, n0 = blockIdx.x * 64;
    float acc[4][4];
    for (int i = 0; i < 4; ++i) for (int j = 0; j < 4; ++j) acc[i][j] = 0.f;
    for (int k0 = 0; k0 < K; k0 += 16) {
        for (int i = tid; i < 64 * 16; i += 256) { const int mm = i >> 4, kk = i & 15; As[kk][mm] = bf2f(A[(size_t)(m0 + mm) * K + k0 + kk]); }
        for (int i = tid; i < 16 * 64; i += 256) { const int kk = i >> 6, nn = i & 63; Ws[kk][nn] = bfr(W[(size_t)(k0 + kk) * N + n0 + nn]); }
        __syncthreads();
        for (int kk = 0; kk < 16; ++kk) { float a[4], b[4];
            for (int i = 0; i < 4; ++i) a[i] = As[kk][ty * 4 + i];
            for (int j = 0; j < 4; ++j) b[j] = Ws[kk][tx * 4 + j];
            for (int i = 0; i < 4; ++i) for (int j = 0; j < 4; ++j) acc[i][j] += a[i] * b[j]; }
        __syncthreads();
    }
    for (int i = 0; i < 4; ++i) for (int j = 0; j < 4; ++j) epi_store<MODE>(e, m0 + ty * 4 + i, n0 + tx * 4 + j, acc[i][j]);
}
__global__ void qknorm_rope(bf16_t* Z, const float* a_qn, const float* a_kn, const float* b_qn, const float* b_kn, const float* rope) {
    const int r = blockIdx.x, grp = blockIdx.y, d = threadIdx.x;
    int col0; const float* gain; float sc;
    if (grp < 8) { col0 = ZQA + grp * 64; gain = a_qn; sc = C2; }
    else if (grp < 10) { col0 = ZKA + (grp - 8) * 64; gain = a_kn; sc = 1.f; }
    else if (grp < 18) { col0 = ZQB + (grp - 10) * 64; gain = b_qn; sc = C2; }
    else { col0 = ZKB + (grp - 18) * 64; gain = b_kn; sc = 1.f; }
    bf16_t* z = Z + (size_t)r * ZW + col0;
    __shared__ float v[64]; __shared__ float red[64];
    const float x = bf2f(z[d]); red[d] = x * x; __syncthreads();
    for (int o = 32; o > 0; o >>= 1) { if (d < o) red[d] += red[d + o]; __syncthreads(); }
    const float rstd = 1.f / sqrtf(red[0] / 64.f + EPS);
    const float y = x * rstd * gain[d]; v[d] = y; __syncthreads();
    float o_ = y;
    if (r < ML) { const int t = r & 2047, k = d & 31; const float cs = rope[t * 32 + k], sn = rope[2048 * 32 + t * 32 + k];
        o_ = d < 32 ? v[d] * cs - v[d + 32] * sn : v[d] * cs + v[d - 32] * sn; }
    z[d] = f2bf(o_ * sc);
}
__global__ void attn_a(const bf16_t* Z, const float* sink, bf16_t* O) {
    const int r = blockIdx.x, h = blockIdx.y, tid = threadIdx.x, kvh = h >> 2;
    __shared__ float q[64]; __shared__ float sc[520]; __shared__ int krow[520]; __shared__ float red[64];
    q[tid] = bf2f(Z[(size_t)r * ZW + ZQA + h * 64 + tid]);
    int nk = 0; int b;
    if (r < ML) { b = r >> 11; const int i = r & 2047; const int j0 = i - 128 < 0 ? 0 : i - 128, j1 = i + 128 > 2047 ? 2047 : i + 128; nk = j1 - j0 + 1;
        for (int j = tid; j < nk; j += 64) krow[j] = b * 2048 + j0 + j; }
    else b = (r - ML) >> 8;
    for (int j = tid; j < 256; j += 64) krow[nk + j] = ML + b * 256 + j;
    nk += 256;
    __syncthreads();
    for (int j = tid; j < nk; j += 64) { const bf16_t* k = Z + (size_t)krow[j] * ZW + ZKA + kvh * 64; float s = 0.f;
#pragma unroll 8
        for (int d = 0; d < 64; ++d) s += q[d] * bf2f(k[d]);
        sc[j] = s; }
    __syncthreads();
    const float sk = sink[h] * LOG2E;
    float m = sk; for (int j = tid; j < nk; j += 64) m = fmaxf(m, sc[j]);
    red[tid] = m; __syncthreads();
    for (int o = 32; o > 0; o >>= 1) { if (tid < o) red[tid] = fmaxf(red[tid], red[tid + o]); __syncthreads(); }
    m = red[0]; __syncthreads();
    float l = 0.f; for (int j = tid; j < nk; j += 64) { const float p = exp2f(sc[j] - m); sc[j] = p; l += p; }
    red[tid] = l; __syncthreads();
    for (int o = 32; o > 0; o >>= 1) { if (tid < o) red[tid] += red[tid + o]; __syncthreads(); }
    l = red[0] + exp2f(sk - m);
    float o_ = 0.f;
#pragma unroll 4
    for (int j = 0; j < nk; ++j) o_ += sc[j] * bf2f(Z[(size_t)krow[j] * ZW + ZVA + kvh * 64 + tid]);
    O[(size_t)r * D + h * 64 + tid] = f2bf(o_ / l);
}
__global__ void attn_b(const bf16_t* Z, const float* lamp, const float* subln, bf16_t* O) {
    const int r = blockIdx.x, h = blockIdx.y, tid = threadIdx.x;
    __shared__ float q[128]; __shared__ float sc[2][2304]; __shared__ float red[128]; __shared__ float stat[4];
    q[tid] = bf2f(Z[(size_t)r * ZW + ZQB + h * 128 + tid]);
    const int b = r < ML ? (r >> 11) : ((r - ML) >> 8);
    const int nk = r < ML ? 2304 : 256;
    __syncthreads();
    for (int j = tid; j < nk; j += 128) { const size_t kr = j < 256 ? (size_t)(ML + b * 256 + j) : (size_t)(b * 2048 + j - 256); const bf16_t* k = Z + kr * ZW + ZKB + h * 128;
        float s1 = 0.f, s2 = 0.f;
#pragma unroll 8
        for (int d = 0; d < 64; ++d) { s1 += q[d] * bf2f(k[d]); s2 += q[64 + d] * bf2f(k[64 + d]); }
        sc[0][j] = s1; sc[1][j] = s2; }
    __syncthreads();
    for (int mp = 0; mp < 2; ++mp) {
        float m = -1e30f; for (int j = tid; j < nk; j += 128) m = fmaxf(m, sc[mp][j]);
        red[tid] = m; __syncthreads();
        for (int o = 64; o > 0; o >>= 1) { if (tid < o) red[tid] = fmaxf(red[tid], red[tid + o]); __syncthreads(); }
        m = red[0]; __syncthreads();
        float l = 0.f; for (int j = tid; j < nk; j += 128) { const float p = exp2f(sc[mp][j] - m); sc[mp][j] = p; l += p; }
        red[tid] = l; __syncthreads();
        for (int o = 64; o > 0; o >>= 1) { if (tid < o) red[tid] += red[tid + o]; __syncthreads(); }
        if (tid == 0) stat[mp] = red[0]; __syncthreads();
    }
    const float lam = lamp[0], i1 = 1.f / stat[0], i2 = lam / stat[1];
    float o_ = 0.f;
#pragma unroll 4
    for (int j = 0; j < nk; ++j) { const size_t kr = j < 256 ? (size_t)(ML + b * 256 + j) : (size_t)(b * 2048 + j - 256);
        const float w = sc[0][j] * i1 - sc[1][j] * i2; o_ += w * bf2f(Z[kr * ZW + ZVB + h * 128 + tid]); }
    red[tid] = o_ * o_; __syncthreads();
    for (int o = 64; o > 0; o >>= 1) { if (tid < o) red[tid] += red[tid + o]; __syncthreads(); }
    const float rstd = 1.f / sqrtf(red[0] / 128.f + EPS);
    O[(size_t)r * D + 512 + h * 128 + tid] = f2bf(o_ * rstd * subln[tid] * (1.f - LAMBDA_INIT0));
}
__device__ __forceinline__ float gelu_tanh(float x) { const float u = 0.7978845608028654f * (x + 0.044715f * x * x * x); return 0.5f * x * (1.f + tanhf(u)); }
__global__ void s5_naive(const bf16_t* U, const float* ab, const float* bb, const float* c_re, const float* c_im, const float* dskip, float* YT, bf16_t* G) {
    const int b = blockIdx.x, g = blockIdx.y, p = threadIdx.x;
    __shared__ float hs[2][64]; __shared__ float us[16]; __shared__ float cs[2][16][64];
    for (int dir = 0; dir < 2; ++dir) {
        const int i = (dir * 64 + g) * 64 + p;
        const float ar = ab[2 * i], ai = ab[2 * i + 1];
        float br[16], bi[16];
        for (int h = 0; h < 16; ++h) { br[h] = bb[(size_t)i * 16 + h]; bi[h] = bb[(size_t)2 * 64 * 64 * 16 + (size_t)i * 16 + h]; }
        __syncthreads();
        for (int j = p; j < 16 * 64; j += 64) { cs[0][j >> 6][j & 63] = c_re[((size_t)(dir * 64 + g) * 16) * 64 + j]; cs[1][j >> 6][j & 63] = c_im[((size_t)(dir * 64 + g) * 16) * 64 + j]; }
        float hr = 0.f, hi = 0.f;
        for (int s = 0; s < 2304; ++s) {
            size_t row; bool lat;
            if (s < 256) { const int t = dir == 0 ? s : 255 - s; row = (size_t)ML + b * 256 + t; lat = false; }
            else { const int t = dir == 0 ? s - 256 : 2047 - (s - 256); row = (size_t)b * 2048 + t; lat = true; }
            __syncthreads();
            if (p < 16) us[p] = bf2f(U[row * D + g * 16 + p]);
            __syncthreads();
            float xr = 0.f, xi = 0.f;
            for (int h = 0; h < 16; ++h) { xr += br[h] * us[h]; xi += bi[h] * us[h]; }
            const float nr = ar * hr - ai * hi + xr, ni = ar * hi + ai * hr + xi; hr = nr; hi = ni;
            if (lat) {
                hs[0][p] = hr; hs[1][p] = hi; __syncthreads();
                if (p < 16) { float y = 0.f; for (int q = 0; q < 64; ++q) y += cs[0][p][q] * hs[0][q] - cs[1][p][q] * hs[1][q];
                    const size_t o = row * D + g * 16 + p;
                    if (dir == 0) YT[o] = us[p] * dskip[g * 16 + p] + y; else G[o] = f2bf(gelu_tanh(YT[o] + y)); }
            }
        }
    }
}
}

extern "C" void kernel_launch(void* const* d_in, const int* in_sizes, int n_in, void* d_out, int out_size, void* d_ws, size_t ws_size, hipStream_t stream) {
    (void)in_sizes; (void)n_in; (void)out_size; (void)ws_size;
    const float* x = (const float*)d_in[0]; const float* c = (const float*)d_in[1]; const float* ctx = (const float*)d_in[2]; const float* c_ctx = (const float*)d_in[3];
    const float* norm1_g = (const float*)d_in[4]; const float* norm2_g = (const float*)d_in[5]; const float* mod_w = (const float*)d_in[6]; const float* mod_b = (const float*)d_in[7];
    const float* mlp_w1 = (const float*)d_in[8]; const float* mlp_w2 = (const float*)d_in[9]; const float* attn_w_in = (const float*)d_in[10]; const float* attn_w_out = (const float*)d_in[11];
    const float* a_qn = (const float*)d_in[12]; const float* a_kn = (const float*)d_in[13]; const float* a_sink = (const float*)d_in[14]; const float* b_qn = (const float*)d_in[15]; const float* b_kn = (const float*)d_in[16];
    const float* lq1 = (const float*)d_in[17]; const float* lk1 = (const float*)d_in[18]; const float* lq2 = (const float*)d_in[19]; const float* lk2 = (const float*)d_in[20]; const float* subln = (const float*)d_in[21];
    const float* s5_w_in = (const float*)d_in[22]; const float* s5_lre = (const float*)d_in[23]; const float* s5_lim = (const float*)d_in[24]; const float* s5_ls = (const float*)d_in[25];
    const float* s5_bre = (const float*)d_in[26]; const float* s5_bim = (const float*)d_in[27]; const float* s5_cre = (const float*)d_in[28]; const float* s5_cim = (const float*)d_in[29];
    const float* s5_d = (const float*)d_in[30]; const float* glu_w = (const float*)d_in[31]; const float* glu_b = (const float*)d_in[32]; const float* s5_w_out = (const float*)d_in[33];
    unsigned char* ws = (unsigned char*)d_ws; float* out = (float*)d_out;
    float* modv = (float*)(ws + WS_MODV); float* rope = (float*)(ws + WS_ROPE); float* s5ab = (float*)(ws + WS_S5AB); float* lam = (float*)(ws + WS_LAM); float* s5bb = (float*)(ws + WS_S5BB);
    float* hctx = (float*)(ws + WS_HCTX); bf16_t* A = (bf16_t*)(ws + WS_A); bf16_t* Z = (bf16_t*)(ws + WS_Z); bf16_t* O = (bf16_t*)(ws + WS_O); bf16_t* U1 = (bf16_t*)(ws + WS_U1);
    bf16_t* U = (bf16_t*)(ws + WS_U); float* YT = (float*)(ws + WS_YT); bf16_t* G = (bf16_t*)(ws + WS_G); bf16_t* G2 = (bf16_t*)(ws + WS_G2);

    nv::mod_gemv<<<dim3(6144 / 256, 2), 256, 0, stream>>>(c, c_ctx, mod_w, mod_b, modv);
    nv::rope_table<<<2048 * 32 / 256, 256, 0, stream>>>(rope);
    nv::s5_disc<<<2 * 64 * 64 / 256, 256, 0, stream>>>(s5_lre, s5_lim, s5_ls, s5_bre, s5_bim, s5ab, s5bb);
    nv::lam_kernel<<<1, 64, 0, stream>>>(lq1, lk1, lq2, lk2, lam);
    const float* modv0 = modv; const float* modv1 = modv + 9 * 6144;
    nv::norm_mod<<<M, 256, 0, stream>>>(x, ctx, norm1_g, modv0, 0, 1, A);
    { nv::Epi e{}; e.obf = Z; e.ldo = ZW; nv::gemm<nv::E_BF16><<<dim3(ZW / 64, M / 64), 256, 0, stream>>>(A, attn_w_in, M, ZW, D, e); }
    nv::qknorm_rope<<<dim3(M, 26), 64, 0, stream>>>(Z, a_qn, a_kn, b_qn, b_kn, rope);
    nv::attn_a<<<dim3(M, 8), 64, 0, stream>>>(Z, a_sink, O);
    nv::attn_b<<<dim3(M, 4), 128, 0, stream>>>(Z, lam, subln, O);
    { nv::Epi e{}; e.hin_lat = x; e.hin_ctx = ctx; e.hout_lat = out; e.hout_ctx = hctx; e.modv_l = modv0; e.gate_idx = 2;
      nv::gemm<nv::E_RESID><<<dim3(D / 64, M / 64), 256, 0, stream>>>(O, attn_w_out, M, D, D, e); }
    nv::norm_mod<<<M, 256, 0, stream>>>(out, hctx, norm2_g, modv0, 3, 4, A);
    { nv::Epi e{}; e.obf = U1; e.ldo = FF; nv::gemm<nv::E_RELU2><<<dim3(FF / 64, M / 64), 256, 0, stream>>>(A, mlp_w1, M, FF, D, e); }
    { nv::Epi e{}; e.hin_lat = out; e.hin_ctx = hctx; e.hout_lat = out; e.hout_ctx = hctx; e.modv_l = modv0; e.gate_idx = 5;
      nv::gemm<nv::E_RESID><<<dim3(D / 64, M / 64), 256, 0, stream>>>(U1, mlp_w2, M, D, FF, e); }
    nv::norm_mod<<<M, 256, 0, stream>>>(out, hctx, norm1_g + D, modv1, 0, 1, A);
    { nv::Epi e{}; e.obf = U; e.ldo = D; nv::gemm<nv::E_BF16><<<dim3(D / 64, M / 64), 256, 0, stream>>>(A, s5_w_in, M, D, D, e); }
    nv::s5_naive<<<dim3(8, 64), 64, 0, stream>>>(U, s5ab, s5bb, s5_cre, s5_cim, s5_d, YT, G);
    { nv::Epi e{}; e.obf = G2; e.ldo = D; e.gin = G; e.bias = glu_b; nv::gemm<nv::E_GLU><<<dim3(D / 64, ML / 64), 256, 0, stream>>>(G, glu_w, ML, D, D, e); }
    { nv::Epi e{}; e.hin_lat = out; e.hin_ctx = hctx; e.hout_lat = out; e.hout_ctx = hctx; e.modv_l = modv1; e.gate_idx = 2;
      nv::gemm<nv::E_RESID><<<dim3(D / 64, ML / 64), 256, 0, stream>>>(G2, s5_w_out, ML, D, D, e); }
    nv::norm_mod<<<ML, 256, 0, stream>>>(out, hctx, norm2_g + D, modv1, 3, 4, A);
    { nv::Epi e{}; e.obf = U1; e.ldo = FF; nv::gemm<nv::E_RELU2><<<dim3(FF / 64, ML / 64), 256, 0, stream>>>(A, mlp_w1 + (size_t)D * FF, ML, FF, D, e); }
    { nv::Epi e{}; e.hin_lat = out; e.hin_ctx = hctx; e.hout_lat = out; e.hout_ctx = hctx; e.modv_l = modv1; e.gate_idx = 5;
      nv::gemm<nv::E_RESID><<<dim3(D / 64, ML / 64), 256, 0, stream>>>(U1, mlp_w2 + (size_t)FF * D, ML, D, FF, e); }
}
```

```cpp
#include <hip/hip_runtime.h>
#include <cstdint>
#include <cstdio>

namespace cfg {
constexpr int D = 1024, B = 8, L = 2048, NC = 256, FF = 4096;
constexpr int ML = B * L, MC = B * NC, M = ML + MC;
constexpr int ZW = 2304;
constexpr int ZQA = 0, ZKA = 512, ZVA = 640, ZQB = 768, ZKB = 1280, ZVB = 1792;
constexpr float EPS = 1e-6f;
constexpr float C2 = 0.125f * 1.4426950408889634f;
constexpr float LOG2E = 1.4426950408889634f;
constexpr float LAMBDA_INIT0 = 0.2f;
constexpr size_t MiB = 1u << 20;
constexpr size_t WS_CTL = 0;
constexpr size_t WS_MODV = 1 * MiB;
constexpr size_t WS_ROPE = 1 * MiB + 512 * 1024;
constexpr size_t WS_S5AB = 2 * MiB;
constexpr size_t WS_LAM = 2 * MiB + 64 * 1024;
constexpr size_t WS_S5BB = 3 * MiB;
constexpr size_t WS_HCTX = 56 * MiB;
constexpr size_t WS_A = 64 * MiB;
constexpr size_t WS_Z = 100 * MiB;
constexpr size_t WS_O = 181 * MiB;
constexpr size_t WS_U1 = 100 * MiB;
constexpr size_t WS_U = 100 * MiB;
constexpr size_t WS_YT = 136 * MiB;
constexpr size_t WS_G = 200 * MiB;
constexpr size_t WS_G2 = 64 * MiB;
}
using namespace cfg;

typedef unsigned short bf16_t;
__device__ __forceinline__ bf16_t f2bf(float f) { unsigned u = __builtin_bit_cast(unsigned, f); return (bf16_t)((u + 0x7fffu + ((u >> 16) & 1u)) >> 16); }
__device__ __forceinline__ float bf2f(bf16_t h) { return __builtin_bit_cast(float, (unsigned)h << 16); }
__device__ __forceinline__ float bfr(float f) { return bf2f(f2bf(f)); }
__device__ __forceinline__ float silu(float x) { return x / (1.f + expf(-x)); }

namespace pg8 {
#define PG8_LAS __attribute__((address_space(3)))
typedef unsigned short bf16_t;
typedef short bf16x8 __attribute__((ext_vector_type(8)));
typedef float f32x4 __attribute__((ext_vector_type(4)));
typedef unsigned u32x4 __attribute__((ext_vector_type(4)));
constexpr int BM = 256, BK = 64, HALF = 128, HTB = HALF * BK * 2  , STAGE_BYTES = 8 * HTB, NXCD = 8, WGM = 8;

__host__ __device__ __forceinline__ int lds_byte(int r, int c) { const int st = (r >> 4) * 2 + (c >> 5), rr = r & 15, cc = c & 31, ob = rr * 64 + cc * 2; return st * 1024 + (ob ^ (((ob >> 9) & 1) << 5)); }
__host__ __device__ __forceinline__ void stage_rc(int b, int& R, int& C) { const int st = b / 1024, sb = b % 1024, swz = sb ^ (((sb >> 9) & 1) << 5); R = (st >> 1) * 16 + swz / 64; C = (st & 1) * 32 + (swz % 64) / 2; }
__host__ __device__ __forceinline__ int perm32(int rho) { const int n = rho >> 4, i = rho & 15; return 8 * (i >> 2) + 4 * n + (i & 3); }

struct Unit { int pm, pn; };
struct Gemm { const bf16_t* A; const bf16_t* Bt; int M, N, K; };

struct StaticOrder {
    int nM, nN, nwg, G, c;
    __host__ __device__ void init(int M, int N, int G_, int c_) { nM = M / BM; nN = N / BM; nwg = nM * nN; G = G_; c = c_; }
    __host__ __device__ bool next(int i, Unit& u) const {
        const long L = (long)i * G + c; if (L >= nwg) return false;
        int wgid = (int)L; { const int q = nwg / NXCD, r = nwg % NXCD, xcd = wgid % NXCD, off = wgid / NXCD; wgid = (xcd < r ? xcd * (q + 1) : r * (q + 1) + (xcd - r) * q) + off; }
        const int nig = WGM * nN, gid = wgid / nig, fm = gid * WGM, gsz = (nM - fm) < WGM ? (nM - fm) : WGM;
        u.pm = fm + ((wgid % nig) % gsz); u.pn = (wgid % nig) / gsz; return true;
    }
    __device__ __forceinline__ void a_ready(const Unit&) const {}
    __device__ __forceinline__ void done(const Unit&) const {}
};

__device__ __forceinline__ unsigned cvt_pk_bf16(float lo, float hi) { unsigned r; asm volatile("v_cvt_pk_bf16_f32 %0, %1, %2" : "=v"(r) : "v"(lo), "v"(hi)); return r; }
typedef float f32x2 __attribute__((ext_vector_type(2)));
template <int ACT  > struct EpiBf16 {
    static constexpr bool PERM = true, AFTER_DRAIN = false;
    bf16_t* O; int ldc;
    __device__ __forceinline__ void operator()(const f32x4 (&acc)[2][2][4][2], const Unit& u, int wr, int wc, int fr, int fq) const {
        const int row0 = u.pm * BM + wr * 64 + fr, col0 = u.pn * BM + wc * 32 + 8 * fq;
#pragma unroll
        for (int ai = 0; ai < 2; ++ai)
#pragma unroll
            for (int m = 0; m < 4; ++m) { bf16_t* rowp = O + (size_t)(row0 + ai * HALF + m * 16) * ldc + col0;
#pragma unroll
                for (int bj = 0; bj < 2; ++bj) { f32x4 v0 = acc[ai][bj][m][0], v1 = acc[ai][bj][m][1];
                    if (ACT == 1) {
#pragma unroll
                        for (int e = 0; e < 4; ++e) { const float a = v0[e] > 0.f ? v0[e] : 0.f, b = v1[e] > 0.f ? v1[e] : 0.f; v0[e] = a * a; v1[e] = b * b; } }
                    u32x4 w; w.x = cvt_pk_bf16(v0[0], v0[1]); w.y = cvt_pk_bf16(v0[2], v0[3]); w.z = cvt_pk_bf16(v1[0], v1[1]); w.w = cvt_pk_bf16(v1[2], v1[3]);
                    *(u32x4*)(rowp + bj * HALF) = w; } }
    }
};
struct EpiResid {
    static constexpr bool PERM = true, AFTER_DRAIN = false;
    const float* hin_lat; const float* hin_ctx; float* hout_lat; float* hout_ctx; const float* gate; int ml_tiles;
    __device__ __forceinline__ void operator()(const f32x4 (&acc)[2][2][4][2], const Unit& u, int wr, int wc, int fr, int fq) const {
        const bool lat = u.pm < ml_tiles; const int b = lat ? (u.pm >> 3) : 8;
        const int prow = (lat ? u.pm : u.pm - ml_tiles) * BM + wr * 64 + fr, col0 = u.pn * BM + wc * 32 + 8 * fq;
        const float* hin = lat ? hin_lat : hin_ctx; float* hout = lat ? hout_lat : hout_ctx;
        f32x4 gv[2][2];
#pragma unroll
        for (int bj = 0; bj < 2; ++bj)
#pragma unroll
            for (int n = 0; n < 2; ++n) gv[bj][n] = *(const f32x4*)(gate + (size_t)b * 6144 + col0 + bj * HALF + 4 * n);
#pragma unroll
        for (int ai = 0; ai < 2; ++ai)
#pragma unroll
            for (int m = 0; m < 4; ++m) { const size_t off = (size_t)(prow + ai * HALF + m * 16) * 1024 + col0;
#pragma unroll
                for (int bj = 0; bj < 2; ++bj)
#pragma unroll
                    for (int n = 0; n < 2; ++n) { const f32x4 h = *(const f32x4*)(hin + off + bj * HALF + 4 * n);
                        *(f32x4*)(hout + off + bj * HALF + 4 * n) = h + gv[bj][n] * acc[ai][bj][m][n]; } }
    }
};
struct EpiGlu {
    static constexpr bool PERM = true, AFTER_DRAIN = false;
    const bf16_t* G; bf16_t* O; const float* bias;
    __device__ __forceinline__ void operator()(const f32x4 (&acc)[2][2][4][2], const Unit& u, int wr, int wc, int fr, int fq) const {
        const int row0 = u.pm * BM + wr * 64 + fr, col0 = u.pn * BM + wc * 32 + 8 * fq;
        f32x4 bv[2][2];
#pragma unroll
        for (int bj = 0; bj < 2; ++bj)
#pragma unroll
            for (int n = 0; n < 2; ++n) bv[bj][n] = *(const f32x4*)(bias + col0 + bj * HALF + 4 * n);
#pragma unroll
        for (int ai = 0; ai < 2; ++ai)
#pragma unroll
            for (int m = 0; m < 4; ++m) { const size_t off = (size_t)(row0 + ai * HALF + m * 16) * 1024 + col0;
#pragma unroll
                for (int bj = 0; bj < 2; ++bj) { const u32x4 gw = *(const u32x4*)(G + off + bj * HALF);
                    float o[8];
#pragma unroll
                    for (int e = 0; e < 8; ++e) { const unsigned wd = gw[e >> 1]; const float gval = __builtin_bit_cast(float, (e & 1) ? (wd & 0xffff0000u) : (wd << 16));
                        const float z = acc[ai][bj][m][e >> 2][e & 3] + bv[bj][e >> 2][e & 3]; o[e] = gval * __builtin_amdgcn_rcpf(1.f + __expf(-z)); }
                    u32x4 w; w.x = cvt_pk_bf16(o[0], o[1]); w.y = cvt_pk_bf16(o[2], o[3]); w.z = cvt_pk_bf16(o[4], o[5]); w.w = cvt_pk_bf16(o[6], o[7]);
                    *(u32x4*)(O + off + bj * HALF) = w; } }
    }
};
template <bool FUSE> struct EpiQKV {
    static constexpr bool PERM = true, AFTER_DRAIN = false;
    bf16_t* Z; const float* a_qn; const float* a_kn; const float* b_qn; const float* b_kn; const float* rope; int ml_tiles;
    __device__ __forceinline__ void operator()(const f32x4 (&acc)[2][2][4][2], const Unit& u, int wr, int wc, int fr, int fq) const {
        const int row0 = u.pm * BM + wr * 64 + fr, colbase = u.pn * BM + wc * 64 + 8 * fq;
        const float* gain = nullptr; float sc = 1.f;
        if (u.pn <= 1) { gain = a_qn; sc = 0.125f * 1.4426950408889634f; }
        else if (u.pn == 2) { if (wc < 2) gain = a_kn; }
        else if (u.pn <= 4) { gain = b_qn; sc = 0.125f * 1.4426950408889634f; }
        else if (u.pn <= 6) gain = b_kn;
        const bool lat = u.pm < ml_tiles;
        if (FUSE && gain != nullptr) {
            f32x4 gv[2][2];
#pragma unroll
            for (int bj = 0; bj < 2; ++bj)
#pragma unroll
                for (int n = 0; n < 2; ++n) gv[bj][n] = *(const f32x4*)(gain + 32 * bj + 8 * fq + 4 * n) * sc;
#pragma unroll
            for (int ai = 0; ai < 2; ++ai)
#pragma unroll
                for (int m = 0; m < 4; ++m) { const int row = row0 + ai * HALF + m * 16;
                    f32x4 v[2][2]; float ss = 0.f;
#pragma unroll
                    for (int bj = 0; bj < 2; ++bj)
#pragma unroll
                        for (int n = 0; n < 2; ++n) { v[bj][n] = acc[ai][bj][m][n]; const f32x4 q = v[bj][n] * v[bj][n]; ss += (q[0] + q[1]) + (q[2] + q[3]); }
                    ss += __shfl_xor(ss, 16); ss += __shfl_xor(ss, 32);
                    const float rstd = 1.f / sqrtf(ss * (1.f / 64.f) + 1e-6f);
#pragma unroll
                    for (int bj = 0; bj < 2; ++bj)
#pragma unroll
                        for (int n = 0; n < 2; ++n) v[bj][n] = v[bj][n] * rstd * gv[bj][n];
                    if (lat) { const int t = row & 2047;
#pragma unroll
                        for (int n = 0; n < 2; ++n) { const f32x4 cs = *(const f32x4*)(rope + t * 32 + 8 * fq + 4 * n), sn = *(const f32x4*)(rope + 2048 * 32 + t * 32 + 8 * fq + 4 * n);
                            const f32x4 x1 = v[0][n], x2 = v[1][n]; v[0][n] = x1 * cs - x2 * sn; v[1][n] = x2 * cs + x1 * sn; } }
#pragma unroll
                    for (int bj = 0; bj < 2; ++bj) { u32x4 w; w.x = cvt_pk_bf16(v[bj][0][0], v[bj][0][1]); w.y = cvt_pk_bf16(v[bj][0][2], v[bj][0][3]); w.z = cvt_pk_bf16(v[bj][1][0], v[bj][1][1]); w.w = cvt_pk_bf16(v[bj][1][2], v[bj][1][3]);
                        *(u32x4*)(Z + (size_t)row * 2304 + colbase + 32 * bj) = w; } }
        } else {
#pragma unroll
            for (int ai = 0; ai < 2; ++ai)
#pragma unroll
                for (int m = 0; m < 4; ++m) { const int row = row0 + ai * HALF + m * 16;
#pragma unroll
                    for (int bj = 0; bj < 2; ++bj) { const f32x4 v0 = acc[ai][bj][m][0], v1 = acc[ai][bj][m][1];
                        u32x4 w; w.x = cvt_pk_bf16(v0[0], v0[1]); w.y = cvt_pk_bf16(v0[2], v0[3]); w.z = cvt_pk_bf16(v1[0], v1[1]); w.w = cvt_pk_bf16(v1[2], v1[3]);
                        *(u32x4*)(Z + (size_t)row * 2304 + colbase + 32 * bj) = w; } }
        }
    }
};
template <class Epi, class Sched, bool ALIGN_EPI = false, bool SP2 = false>
__device__ __forceinline__ void gemm_phase(PG8_LAS unsigned char* lds, const Gemm g, const Sched& S, const Epi& E) {
    const int tid = threadIdx.x, wid = __builtin_amdgcn_readfirstlane(tid >> 6), lane = tid & 63, wr = wid >> 2, wc = wid & 3, fr = lane & 15, fq = lane >> 4;
    const int K = g.K, nt = K / BK;
    unsigned voffA[2], voffB[2];
#pragma unroll
    for (int i = 0; i < 2; ++i) { int R, C; stage_rc(tid * 16 + i * 8192, R, C); const int Rb = Epi::PERM ? ((R & ~31) + perm32(R & 31)) : R;
        voffA[i] = (unsigned)(R * K + C) * 2u; voffB[i] = (unsigned)(Rb * K + C) * 2u; }
    const size_t kstep = (size_t)(BK * 2);
    const size_t hstep = (size_t)HALF * K * 2;
    const size_t tstep = 2 * hstep;
    const unsigned ldsw = (unsigned)wid * 1024u;
    const int aoff = lds_byte(wr * 64 + fr, fq * 8), boff = lds_byte(wc * 32 + fr, fq * 8);
#define PG8_SA(b, h) (((b) * 2 + (h)) * HTB)
#define PG8_SB(b, h) ((4 + (b) * 2 + (h)) * HTB)
#define PG8_STAGE(bufoff, gbase, voff) do { _Pragma("unroll") for (int _i = 0; _i < 2; ++_i) \
        __builtin_amdgcn_global_load_lds((const unsigned*)((const char*)(gbase) + (voff)[_i]), (PG8_LAS unsigned*)(lds + (bufoff) + ldsw + _i * 8192), 16, 0, 0); } while (0)
#define PG8_LDA(dst, b, h) do { _Pragma("unroll") for (int m = 0; m < 4; ++m) _Pragma("unroll") for (int k = 0; k < 2; ++k) dst[m][k] = *(const PG8_LAS bf16x8*)(lds + PG8_SA(b, h) + aoff + m * 2048 + k * 1024); } while (0)
#define PG8_LDB(dst, b, h) do { _Pragma("unroll") for (int n = 0; n < 2; ++n) _Pragma("unroll") for (int k = 0; k < 2; ++k) dst[n][k] = *(const PG8_LAS bf16x8*)(lds + PG8_SB(b, h) + boff + n * 2048 + k * 1024); } while (0)
#define PG8_MMA(ai, bj, At, Bt) do { __builtin_amdgcn_s_setprio(1); _Pragma("unroll") for (int m = 0; m < 4; ++m) _Pragma("unroll") for (int n = 0; n < 2; ++n) _Pragma("unroll") for (int k = 0; k < 2; ++k) \
        acc[ai][bj][m][n] = __builtin_amdgcn_mfma_f32_16x16x32_bf16(Bt[n][k], At[m][k], acc[ai][bj][m][n], 0, 0, 0); __builtin_amdgcn_s_setprio(0); } while (0)
#define PG8_WAIT_V(n) asm volatile("s_waitcnt vmcnt(" #n ")" ::: "memory")
#define PG8_WAIT_L(n) asm volatile("s_waitcnt lgkmcnt(" #n ")" ::: "memory")
#define PG8_BAR __builtin_amdgcn_s_barrier()
#define PG8_SCHED __builtin_amdgcn_sched_barrier(0)
    Unit cur, nxt; int ui = 0;
    if (!S.next(0, cur)) return;
    f32x4 acc[2][2][4][2];
#pragma unroll
    for (int a = 0; a < 2; ++a)
#pragma unroll
        for (int b = 0; b < 2; ++b)
#pragma unroll
            for (int m = 0; m < 4; ++m)
#pragma unroll
                for (int n = 0; n < 2; ++n) acc[a][b][m][n] = (f32x4){0.f, 0.f, 0.f, 0.f};
    bf16x8 At[4][2], B0[2][2], B1[2][2];
    const char* cA = (const char*)g.A + (size_t)cur.pm * tstep; const char* cB = (const char*)g.Bt + (size_t)cur.pn * tstep;
    S.a_ready(cur);
    if constexpr (SP2) {
        PG8_STAGE(PG8_SB(0, 0), cB, voffB); PG8_STAGE(PG8_SB(0, 1), cB + hstep, voffB); PG8_STAGE(PG8_SA(0, 0), cA, voffA); PG8_STAGE(PG8_SA(0, 1), cA + hstep, voffA);
        if (wr == 1) PG8_BAR;
        PG8_WAIT_V(2); PG8_BAR;
        PG8_STAGE(PG8_SB(1, 0), cB + kstep, voffB); PG8_STAGE(PG8_SA(1, 0), cA + kstep, voffA); PG8_STAGE(PG8_SB(1, 1), cB + hstep + kstep, voffB);
        PG8_WAIT_V(6); PG8_BAR;
    } else {
        PG8_STAGE(PG8_SB(0, 0), cB, voffB); PG8_STAGE(PG8_SA(0, 0), cA, voffA); PG8_STAGE(PG8_SB(0, 1), cB + hstep, voffB); PG8_STAGE(PG8_SA(0, 1), cA + hstep, voffA);
        if (wr == 1) PG8_BAR;
        PG8_WAIT_V(4); PG8_BAR;
        PG8_STAGE(PG8_SB(1, 0), cB + kstep, voffB); PG8_STAGE(PG8_SA(1, 0), cA + kstep, voffA); PG8_STAGE(PG8_SB(1, 1), cB + hstep + kstep, voffB);
        PG8_WAIT_V(6); PG8_BAR;
    }
    for (;;) {
        const bool has_next = S.next(ui + 1, nxt);
        const char* nA = has_next ? (const char*)g.A + (size_t)nxt.pm * tstep : cA; const char* nB = has_next ? (const char*)g.Bt + (size_t)nxt.pn * tstep : cB;
        for (int t = 0; t < nt; t += 2) {
            const bool last = (t == nt - 2);
            const char* a1 = cA + (size_t)(t + 1) * kstep;
            const char* a2 = last ? nA : cA + (size_t)(t + 2) * kstep; const char* b2 = last ? nB : cB + (size_t)(t + 2) * kstep;
            const char* a3 = a2 + kstep; const char* b3 = b2 + kstep;
            if (last && has_next) S.a_ready(nxt);
            if constexpr (SP2) {
            PG8_LDB(B0, 0, 0); PG8_LDB(B1, 0, 1); PG8_SCHED; PG8_LDA(At, 0, 0); PG8_STAGE(PG8_SA(1, 1), a1 + hstep, voffA);
            PG8_WAIT_V(8); PG8_WAIT_L(0); PG8_BAR; PG8_MMA(0, 0, At, B0); PG8_MMA(0, 1, At, B1); PG8_BAR; PG8_SCHED;
            PG8_LDA(At, 0, 1); PG8_STAGE(PG8_SB(0, 0), b2, voffB); PG8_STAGE(PG8_SB(0, 1), b2 + hstep, voffB); PG8_STAGE(PG8_SA(0, 0), a2, voffA);
            PG8_WAIT_V(8); PG8_WAIT_L(0); PG8_BAR; PG8_MMA(1, 0, At, B0); PG8_MMA(1, 1, At, B1); PG8_BAR; PG8_SCHED;
            PG8_LDB(B0, 1, 0); PG8_LDB(B1, 1, 1); PG8_SCHED; PG8_LDA(At, 1, 0); PG8_STAGE(PG8_SA(0, 1), a2 + hstep, voffA);
            PG8_WAIT_V(8); PG8_WAIT_L(0); PG8_BAR; PG8_MMA(0, 0, At, B0); PG8_MMA(0, 1, At, B1); PG8_BAR; PG8_SCHED;
            PG8_LDA(At, 1, 1); PG8_STAGE(PG8_SB(1, 0), b3, voffB); PG8_STAGE(PG8_SB(1, 1), b3 + hstep, voffB); PG8_STAGE(PG8_SA(1, 0), a3, voffA);
            PG8_WAIT_V(8); PG8_WAIT_L(0); PG8_BAR; PG8_MMA(1, 0, At, B0); PG8_MMA(1, 1, At, B1); PG8_BAR; PG8_SCHED;
            } else {
            PG8_LDB(B0, 0, 0); PG8_SCHED; PG8_LDA(At, 0, 0); PG8_STAGE(PG8_SA(1, 1), a1 + hstep, voffA);
            PG8_WAIT_L(8); PG8_BAR; PG8_WAIT_L(0); PG8_MMA(0, 0, At, B0); PG8_BAR; PG8_SCHED;
            PG8_LDB(B1, 0, 1); PG8_STAGE(PG8_SB(0, 0), b2, voffB);
            PG8_BAR; PG8_WAIT_L(0); PG8_MMA(0, 1, At, B1); PG8_BAR;
            PG8_LDA(At, 0, 1); PG8_STAGE(PG8_SA(0, 0), a2, voffA);
            PG8_BAR; PG8_WAIT_L(0); PG8_MMA(1, 0, At, B0); PG8_BAR; PG8_SCHED;
            PG8_STAGE(PG8_SB(0, 1), b2 + hstep, voffB);
            PG8_WAIT_V(6); PG8_BAR; PG8_MMA(1, 1, At, B1); PG8_BAR;
            PG8_LDB(B0, 1, 0); PG8_SCHED; PG8_LDA(At, 1, 0); PG8_STAGE(PG8_SA(0, 1), a2 + hstep, voffA);
            PG8_WAIT_L(8); PG8_BAR; PG8_WAIT_L(0); PG8_MMA(0, 0, At, B0); PG8_BAR; PG8_SCHED;
            PG8_LDB(B1, 1, 1); PG8_STAGE(PG8_SB(1, 0), b3, voffB);
            PG8_BAR; PG8_WAIT_L(0); PG8_MMA(0, 1, At, B1); PG8_BAR;
            PG8_LDA(At, 1, 1); PG8_STAGE(PG8_SA(1, 0), a3, voffA);
            PG8_BAR; PG8_WAIT_L(0); PG8_MMA(1, 0, At, B0); PG8_BAR; PG8_SCHED;
            PG8_STAGE(PG8_SB(1, 1), b3 + hstep, voffB);
            PG8_WAIT_V(6); PG8_BAR; PG8_MMA(1, 1, At, B1); PG8_BAR;
            }
        }
        if constexpr (ALIGN_EPI) { if (wr == 0) PG8_BAR; }
        if constexpr (!Epi::AFTER_DRAIN) { E(acc, cur, wr, wc, fr, fq); S.done(cur); }
        if (!has_next) break;
#pragma unroll
        for (int a = 0; a < 2; ++a)
#pragma unroll
            for (int b = 0; b < 2; ++b)
#pragma unroll
                for (int m = 0; m < 4; ++m)
#pragma unroll
                    for (int n = 0; n < 2; ++n) acc[a][b][m][n] = (f32x4){0.f, 0.f, 0.f, 0.f};
        cur = nxt; cA = nA; cB = nB; ++ui;
        if constexpr (ALIGN_EPI) { if (wr == 1) PG8_BAR; }
    }
    PG8_WAIT_V(0);
    if constexpr (!ALIGN_EPI) { if (wr == 0) PG8_BAR; }
    PG8_BAR;
    if constexpr (Epi::AFTER_DRAIN) { E.fused(acc, cur, wr, wc, fr, fq, lds, wid, lane); S.done(cur); }
#undef PG8_SA
#undef PG8_SB
#undef PG8_STAGE
#undef PG8_LDA
#undef PG8_LDB
#undef PG8_MMA
#undef PG8_WAIT_V
#undef PG8_WAIT_L
#undef PG8_BAR
#undef PG8_SCHED
}
}
namespace nv {
__global__ void mod_gemv(const float* c, const float* c_ctx, const float* mod_w, const float* mod_b, float* modv) {
    const int n = blockIdx.x * 256 + threadIdx.x, l = blockIdx.y;
    __shared__ float s[9][1024];
    for (int i = threadIdx.x; i < 9 * 1024; i += 256) { const int r = i >> 10, k = i & 1023; s[r][k] = silu(r < 8 ? c[r * 1024 + k] : c_ctx[k]); }
    __syncthreads();
    float acc[9];
    for (int r = 0; r < 9; ++r) acc[r] = 0.f;
    const float* w = mod_w + (size_t)l * 1024 * 6144 + n;
    for (int k = 0; k < 1024; ++k) { const float wv = w[(size_t)k * 6144];
        for (int r = 0; r < 9; ++r) acc[r] += s[r][k] * wv; }
    for (int r = 0; r < 9; ++r) modv[((size_t)l * 9 + r) * 6144 + n] = acc[r] + mod_b[l * 6144 + n];
}
__global__ void rope_table(float* rope) {
    const int i = blockIdx.x * 256 + threadIdx.x; if (i >= 2048 * 32) return;
    const int t = i >> 5, k = i & 31; const int f = k & 15;
    const float inv = powf(10000.f, -(float)f / 16.f);
    const float pos = (k < 16) ? (float)(t >> 6) : (float)(t & 63);
    const float ang = pos * inv;
    rope[i] = cosf(ang); rope[2048 * 32 + i] = sinf(ang);
}
__global__ void s5_disc(const float* lam_re, const float* lam_im, const float* log_step, const float* b_re, const float* b_im, float* ab, float* bb) {
    const int i = blockIdx.x * 256 + threadIdx.x; if (i >= 2 * 64 * 64) return;
    const int dg = i >> 6;
    const float lr = lam_re[i], li = lam_im[i], dt = expf(log_step[dg]);
    const float mag = expf(lr * dt), ar = mag * cosf(li * dt), ai = mag * sinf(li * dt);
    const float den = lr * lr + li * li, nr = ar - 1.f;
    const float fr = (nr * lr + ai * li) / den, fi = (ai * lr - nr * li) / den;
    ab[2 * i] = ar; ab[2 * i + 1] = ai;
    for (int h = 0; h < 16; ++h) { const float br = b_re[(size_t)i * 16 + h], bi = b_im[(size_t)i * 16 + h];
        bb[(size_t)i * 16 + h] = fr * br - fi * bi; bb[(size_t)2 * 64 * 64 * 16 + (size_t)i * 16 + h] = fr * bi + fi * br; }
}
__global__ void lam_kernel(const float* lq1, const float* lk1, const float* lq2, const float* lk2, float* lam) {
    if (threadIdx.x == 0) { float s1 = 0.f, s2 = 0.f; for (int i = 0; i < 64; ++i) { s1 += lq1[i] * lk1[i]; s2 += lq2[i] * lk2[i]; } lam[0] = expf(s1) - expf(s2) + LAMBDA_INIT0; }
}
__global__ void norm_mod(const float* src_lat, const float* src_ctx, const float* g, const float* modv_l, int shift_idx, int scale_idx, bf16_t* out) {
    const int r = blockIdx.x, tid = threadIdx.x;
    const float* x = r < ML ? src_lat + (size_t)r * D : src_ctx + (size_t)(r - ML) * D;
    const int mr = r < ML ? (r >> 11) : 8;
    const float* mv = modv_l + (size_t)mr * 6144;
    float v[4]; float ss = 0.f;
    for (int j = 0; j < 4; ++j) { v[j] = x[tid + 256 * j]; ss += v[j] * v[j]; }
    __shared__ float red[256];
    red[tid] = ss; __syncthreads();
    for (int o = 128; o > 0; o >>= 1) { if (tid < o) red[tid] += red[tid + o]; __syncthreads(); }
    const float rstd = 1.f / sqrtf(red[0] / (float)D + EPS);
    for (int j = 0; j < 4; ++j) { const int col = tid + 256 * j;
        out[(size_t)r * D + col] = f2bf(v[j] * rstd * g[col] * (1.f + mv[scale_idx * 1024 + col]) + mv[shift_idx * 1024 + col]); }
}
struct Epi {
    bf16_t* obf; int ldo;
    const float* hin_lat; const float* hin_ctx; float* hout_lat; float* hout_ctx;
    const float* modv_l; int gate_idx;
    const bf16_t* gin; const float* bias;
};
enum { E_BF16 = 0, E_RELU2 = 1, E_RESID = 2, E_GLU = 3 };
template <int MODE> __device__ __forceinline__ void epi_store(const Epi& e, int row, int col, float acc) {
    if (MODE == E_BF16) e.obf[(size_t)row * e.ldo + col] = f2bf(acc);
    else if (MODE == E_RELU2) { const float r = acc > 0.f ? acc : 0.f; e.obf[(size_t)row * e.ldo + col] = f2bf(r * r); }
    else if (MODE == E_RESID) {
        if (row < ML) { const float gate = e.modv_l[(size_t)(row >> 11) * 6144 + e.gate_idx * 1024 + col]; e.hout_lat[(size_t)row * D + col] = e.hin_lat[(size_t)row * D + col] + gate * acc; }
        else { const float gate = e.modv_l[(size_t)8 * 6144 + e.gate_idx * 1024 + col]; const size_t o = (size_t)(row - ML) * D + col; e.hout_ctx[o] = e.hin_ctx[o] + gate * acc; }
    } else if (MODE == E_GLU) { const float gv = bf2f(e.gin[(size_t)row * D + col]); const float z = acc + e.bias[col]; e.obf[(size_t)row * e.ldo + col] = f2bf(gv / (1.f + expf(-z))); }
}
template <int MODE> __global__ void __launch_bounds__(256) gemm(const bf16_t* A, const float* W, int Mr, int N, int K, Epi e) {
    __shared__ float As[16][65]; __shared__ float Ws[16][65];
    const int tid = threadIdx.x, tx = tid & 15, ty = tid >> 4;
    const int m0 = blockIdx.y * 64, n0 = blockIdx.x * 64;
    float acc[4][4];
    for (int i = 0; i < 4; ++i) for (int j = 0; j < 4; ++j) acc[i][j] = 0.f;
    for (int k0 = 0; k0 < K; k0 += 16) {
        for (int i = tid; i < 64 * 16; i += 256) { const int mm = i >> 4, kk = i & 15; As[kk][mm] = bf2f(A[(size_t)(m0 + mm) * K + k0 + kk]); }
        for (int i = tid; i < 16 * 64; i += 256) { const int kk = i >> 6, nn = i & 63; Ws[kk][nn] = bfr(W[(size_t)(k0 + kk) * N + n0 + nn]); }
        __syncthreads();
        for (int kk = 0; kk < 16; ++kk) { float a[4], b[4];
            for (int i = 0; i < 4; ++i) a[i] = As[kk][ty * 4 + i];
            for (int j = 0; j < 4; ++j) b[j] = Ws[kk][tx * 4 + j];
            for (int i = 0; i < 4; ++i) for (int j = 0; j < 4; ++j) acc[i][j] += a[i] * b[j]; }
        __syncthreads();
    }
    for (int i = 0; i < 4; ++i) for (int j = 0; j < 4; ++j) epi_store<MODE>(e, m0 + ty * 4 + i, n0 + tx * 4 + j, acc[i][j]);
}
__global__ void qknorm_rope(bf16_t* Z, const float* a_qn, const float* a_kn, const float* b_qn, const float* b_kn, const float* rope) {
    const int r = blockIdx.x, grp = blockIdx.y, d = threadIdx.x;
    int col0; const float* gain; float sc;
    if (grp < 8) { col0 = ZQA + grp * 64; gain = a_qn; sc = C2; }
    else if (grp < 10) { col0 = ZKA + (grp - 8) * 64; gain = a_kn; sc = 1.f; }
    else if (grp < 18) { col0 = ZQB + (grp - 10) * 64; gain = b_qn; sc = C2; }
    else { col0 = ZKB + (grp - 18) * 64; gain = b_kn; sc = 1.f; }
    bf16_t* z = Z + (size_t)r * ZW + col0;
    __shared__ float v[64]; __shared__ float red[64];
    const float x = bf2f(z[d]); red[d] = x * x; __syncthreads();
    for (int o = 32; o > 0; o >>= 1) { if (d < o) red[d] += red[d + o]; __syncthreads(); }
    const float rstd = 1.f / sqrtf(red[0] / 64.f + EPS);
    const float y = x * rstd * gain[d]; v[d] = y; __syncthreads();
    float o_ = y;
    if (r < ML) { const int t = r & 2047, k = d & 31; const float cs = rope[t * 32 + k], sn = rope[2048 * 32 + t * 32 + k];
        o_ = d < 32 ? v[d] * cs - v[d + 32] * sn : v[d] * cs + v[d - 32] * sn; }
    z[d] = f2bf(o_ * sc);
}
__global__ void attn_a(const bf16_t* Z, const float* sink, bf16_t* O) {
    const int r = blockIdx.x, h = blockIdx.y, tid = threadIdx.x, kvh = h >> 2;
    __shared__ float q[64]; __shared__ float sc[520]; __shared__ int krow[520]; __shared__ float red[64];
    q[tid] = bf2f(Z[(size_t)r * ZW + ZQA + h * 64 + tid]);
    int nk = 0; int b;
    if (r < ML) { b = r >> 11; const int i = r & 2047; const int j0 = i - 128 < 0 ? 0 : i - 128, j1 = i + 128 > 2047 ? 2047 : i + 128; nk = j1 - j0 + 1;
        for (int j = tid; j < nk; j += 64) krow[j] = b * 2048 + j0 + j; }
    else b = (r - ML) >> 8;
    for (int j = tid; j < 256; j += 64) krow[nk + j] = ML + b * 256 + j;
    nk += 256;
    __syncthreads();
    for (int j = tid; j < nk; j += 64) { const bf16_t* k = Z + (size_t)krow[j] * ZW + ZKA + kvh * 64; float s = 0.f;
#pragma unroll 8
        for (int d = 0; d < 64; ++d) s += q[d] * bf2f(k[d]);
        sc[j] = s; }
    __syncthreads();
    const float sk = sink[h] * LOG2E;
    float m = sk; for (int j = tid; j < nk; j += 64) m = fmaxf(m, sc[j]);
    red[tid] = m; __syncthreads();
    for (int o = 32; o > 0; o >>= 1) { if (tid < o) red[tid] = fmaxf(red[tid], red[tid + o]); __syncthreads(); }
    m = red[0]; __syncthreads();
    float l = 0.f; for (int j = tid; j < nk; j += 64) { const float p = exp2f(sc[j] - m); sc[j] = p; l += p; }
    red[tid] = l; __syncthreads();
    for (int o = 32; o > 0; o >>= 1) { if (tid < o) red[tid] += red[tid + o]; __syncthreads(); }
    l = red[0] + exp2f(sk - m);
    float o_ = 0.f;
#pragma unroll 4
    for (int j = 0; j < nk; ++j) o_ += sc[j] * bf2f(Z[(size_t)krow[j] * ZW + ZVA + kvh * 64 + tid]);
    O[(size_t)r * D + h * 64 + tid] = f2bf(o_ / l);
}
__global__ void attn_b(const bf16_t* Z, const float* lamp, const float* subln, bf16_t* O) {
    const int r = blockIdx.x, h = blockIdx.y, tid = threadIdx.x;
    __shared__ float q[128]; __shared__ float sc[2][2304]; __shared__ float red[128]; __shared__ float stat[4];
    q[tid] = bf2f(Z[(size_t)r * ZW + ZQB + h * 128 + tid]);
    const int b = r < ML ? (r >> 11) : ((r - ML) >> 8);
    const int nk = r < ML ? 2304 : 256;
    __syncthreads();
    for (int j = tid; j < nk; j += 128) { const size_t kr = j < 256 ? (size_t)(ML + b * 256 + j) : (size_t)(b * 2048 + j - 256); const bf16_t* k = Z + kr * ZW + ZKB + h * 128;
        float s1 = 0.f, s2 = 0.f;
#pragma unroll 8
        for (int d = 0; d < 64; ++d) { s1 += q[d] * bf2f(k[d]); s2 += q[64 + d] * bf2f(k[64 + d]); }
        sc[0][j] = s1; sc[1][j] = s2; }
    __syncthreads();
    for (int mp = 0; mp < 2; ++mp) {
        float m = -1e30f; for (int j = tid; j < nk; j += 128) m = fmaxf(m, sc[mp][j]);
        red[tid] = m; __syncthreads();
        for (int o = 64; o > 0; o >>= 1) { if (tid < o) red[tid] = fmaxf(red[tid], red[tid + o]); __syncthreads(); }
        m = red[0]; __syncthreads();
        float l = 0.f; for (int j = tid; j < nk; j += 128) { const float p = exp2f(sc[mp][j] - m); sc[mp][j] = p; l += p; }
        red[tid] = l; __syncthreads();
        for (int o = 64; o > 0; o >>= 1) { if (tid < o) red[tid] += red[tid + o]; __syncthreads(); }
        if (tid == 0) stat[mp] = red[0]; __syncthreads();
    }
    const float lam = lamp[0], i1 = 1.f / stat[0], i2 = lam / stat[1];
    float o_ = 0.f;
#pragma unroll 4
    for (int j = 0; j < nk; ++j) { const size_t kr = j < 256 ? (size_t)(ML + b * 256 + j) : (size_t)(b * 2048 + j - 256);
        const float w = sc[0][j] * i1 - sc[1][j] * i2; o_ += w * bf2f(Z[kr * ZW + ZVB + h * 128 + tid]); }
    red[tid] = o_ * o_; __syncthreads();
    for (int o = 64; o > 0; o >>= 1) { if (tid < o) red[tid] += red[tid + o]; __syncthreads(); }
    const float rstd = 1.f / sqrtf(red[0] / 128.f + EPS);
    O[(size_t)r * D + 512 + h * 128 + tid] = f2bf(o_ * rstd * subln[tid] * (1.f - LAMBDA_INIT0));
}
__device__ __forceinline__ float gelu_tanh(float x) { const float u = 0.7978845608028654f * (x + 0.044715f * x * x * x); return 0.5f * x * (1.f + tanhf(u)); }
__global__ void s5_naive(const bf16_t* U, const float* ab, const float* bb, const float* c_re, const float* c_im, const float* dskip, float* YT, bf16_t* G) {
    const int b = blockIdx.x, g = blockIdx.y, p = threadIdx.x;
    __shared__ float hs[2][64]; __shared__ float us[16]; __shared__ float cs[2][16][64];
    for (int dir = 0; dir < 2; ++dir) {
        const int i = (dir * 64 + g) * 64 + p;
        const float ar = ab[2 * i], ai = ab[2 * i + 1];
        float br[16], bi[16];
        for (int h = 0; h < 16; ++h) { br[h] = bb[(size_t)i * 16 + h]; bi[h] = bb[(size_t)2 * 64 * 64 * 16 + (size_t)i * 16 + h]; }
        __syncthreads();
        for (int j = p; j < 16 * 64; j += 64) { cs[0][j >> 6][j & 63] = c_re[((size_t)(dir * 64 + g) * 16) * 64 + j]; cs[1][j >> 6][j & 63] = c_im[((size_t)(dir * 64 + g) * 16) * 64 + j]; }
        float hr = 0.f, hi = 0.f;
        for (int s = 0; s < 2304; ++s) {
            size_t row; bool lat;
            if (s < 256) { const int t = dir == 0 ? s : 255 - s; row = (size_t)ML + b * 256 + t; lat = false; }
            else { const int t = dir == 0 ? s - 256 : 2047 - (s - 256); row = (size_t)b * 2048 + t; lat = true; }
            __syncthreads();
            if (p < 16) us[p] = bf2f(U[row * D + g * 16 + p]);
            __syncthreads();
            float xr = 0.f, xi = 0.f;
            for (int h = 0; h < 16; ++h) { xr += br[h] * us[h]; xi += bi[h] * us[h]; }
            const float nr = ar * hr - ai * hi + xr, ni = ar * hi + ai * hr + xi; hr = nr; hi = ni;
            if (lat) {
                hs[0][p] = hr; hs[1][p] = hi; __syncthreads();
                if (p < 16) { float y = 0.f; for (int q = 0; q < 64; ++q) y += cs[0][p][q] * hs[0][q] - cs[1][p][q] * hs[1][q];
                    const size_t o = row * D + g * 16 + p;
                    if (dir == 0) YT[o] = us[p] * dskip[g * 16 + p] + y; else G[o] = f2bf(gelu_tanh(YT[o] + y)); }
            }
        }
    }
}
}

constexpr int NWAVES = 8;
constexpr int RING_OFF = 0, RING_BYTES = 131072;
constexpr int LDSCTL_OFF = RING_BYTES, MISC_OFF = LDSCTL_OFF + 320;
constexpr int LDS_BYTES = 147456;
constexpr size_t WS_WQKV = 8 * MiB;
constexpr size_t WS_WO = 13 * MiB;
constexpr size_t WS_W1 = 15 * MiB;
constexpr size_t WS_W2 = 31 * MiB;
constexpr size_t WS_WS5IN = 47 * MiB, WS_WGLU = 49 * MiB, WS_WS5OUT = 51 * MiB;
constexpr int CW_BAR = 4096;
constexpr int CW_QUEUE = 16384;

#define GAS __attribute__((address_space(1)))
#define LAS __attribute__((address_space(3)))
typedef unsigned v4u __attribute__((ext_vector_type(4)));
typedef float f32x4 __attribute__((ext_vector_type(4)));
typedef GAS unsigned gu32;
#define RLX_AGENT __ATOMIC_RELAXED, __HIP_MEMORY_SCOPE_AGENT
#define LDS_WAIT() asm volatile("s_waitcnt lgkmcnt(0)" ::: "memory")
#define VM_WAIT() asm volatile("s_waitcnt vmcnt(0)" ::: "memory")
__device__ __forceinline__ unsigned pk2(float lo, float hi) { return (unsigned)f2bf(lo) | ((unsigned)f2bf(hi) << 16); }

#define XB_TMO      128
#define XB_XCNT(j)  (256  + 64 * (j))
#define XB_XSUB(j)  (1280 + 64 * (j))
#define XB_XGEN(j)  (2304 + 64 * (j))
#define XB_TOP      3328
#define XB_TOPGEN   3392
#define XCD_BAR_WORDS 3456
#define XB_SPIN_CAP (1u << 18)

__device__ __forceinline__ unsigned xb_ld(unsigned* p)              { return __hip_atomic_load(p, __ATOMIC_RELAXED, __HIP_MEMORY_SCOPE_AGENT); }
__device__ __forceinline__ unsigned xb_add(unsigned* p, unsigned v) { return __hip_atomic_fetch_add(p, v, __ATOMIC_RELAXED, __HIP_MEMORY_SCOPE_AGENT); }
__device__ __forceinline__ unsigned xb_xcc_id() { return (unsigned)__builtin_amdgcn_s_getreg((3 << 11) | 20) & 0xFu; }
#define XB_SPIN(cond, bar) do { unsigned _sp = 0; while (cond) { __builtin_amdgcn_s_sleep(1); \
    if ((++_sp & 255u) == 0u) { if (xb_ld(&(bar)[XB_TMO])) break; if (_sp > XB_SPIN_CAP) { atomicAdd(&(bar)[XB_TMO], 1u); break; } } } } while (0)

struct XcdBarrier {
    unsigned* bar; unsigned x;
    volatile LAS unsigned* st;
};

__device__ __forceinline__ XcdBarrier xcd_barrier_post(unsigned* bar, volatile LAS unsigned* st) {
    XcdBarrier b; b.bar = bar; b.x = xb_xcc_id(); b.st = st;
    if (threadIdx.x == 0) (void)xb_add(&bar[XB_XCNT(b.x)], 1u);
    return b;
}
__device__ __forceinline__ void xcd_barrier_complete(unsigned* bar, unsigned x, unsigned& nloc, unsigned& nx) {
    const unsigned G = gridDim.x * gridDim.y * gridDim.z;
    unsigned sum, cnt, mine, sp = 0u;
    for (;;) {
        sum = 0u; cnt = 0u; mine = 0u;
#pragma unroll
        for (unsigned j = 0; j < 16; ++j) { const unsigned c = xb_ld(&bar[XB_XCNT(j)]); sum += c; cnt += (c > 0u) ? 1u : 0u; mine = (j == x) ? c : mine; }
        if (sum == G) break;
        __builtin_amdgcn_s_sleep(1);
        if ((++sp & 255u) == 0u) { if (xb_ld(&bar[XB_TMO])) break; if (sp > XB_SPIN_CAP) { atomicAdd(&bar[XB_TMO], 1u); break; } }
    }
    nloc = mine > 0u ? mine : 1u; nx = cnt > 0u ? cnt : 1u;
}

__device__ __forceinline__ void xcd_barrier(const XcdBarrier& b) {
    asm volatile("s_waitcnt vmcnt(0)" ::: "memory");
    __syncthreads();
    if (threadIdx.x == 0) {
        unsigned* bar = b.bar;
        __builtin_amdgcn_s_waitcnt(0);
        unsigned nloc = b.st[0], nx = b.st[1];
        if (nloc == 0u) { xcd_barrier_complete(bar, b.x, nloc, nx); b.st[0] = nloc; b.st[1] = nx; }
        const unsigned old = xb_add(&bar[XB_XSUB(b.x)], 1u);
        const unsigned gen = old / nloc;
        if (old + 1u == (gen + 1u) * nloc) {
            __builtin_amdgcn_fence(__ATOMIC_RELEASE, "agent");
            asm volatile("s_waitcnt vmcnt(0)" ::: "memory");
            const unsigned og = xb_add(&bar[XB_TOP], 1u);
            const unsigned tg = og / nx;
            if (og + 1u == (tg + 1u) * nx) xb_add(&bar[XB_TOPGEN], 1u);
            else XB_SPIN(xb_ld(&bar[XB_TOPGEN]) == tg, bar);
            __builtin_amdgcn_fence(__ATOMIC_ACQUIRE, "agent");
            xb_add(&bar[XB_XGEN(b.x)], 1u);
            asm volatile("s_waitcnt vmcnt(0)" ::: "memory");
        } else {
            XB_SPIN(xb_ld(&bar[XB_XGEN(b.x)]) == gen, bar);
            __builtin_amdgcn_fence(__ATOMIC_ACQUIRE, "agent");
            asm volatile("s_waitcnt vmcnt(0)" ::: "memory");
        }
    }
    __syncthreads();
}

struct Args {
    const float* in[34]; float* out; unsigned char* ws; int ph_lo, ph_hi;
};
struct Frame {
    LAS unsigned char* lds; volatile LAS unsigned* MISC; gu32* ctl;
    int tid, lane, wave, vcu, G;
};
__device__ __forceinline__ float wave_sum(float v) {
#pragma unroll
    for (int o = 1; o < 64; o <<= 1) v += __shfl_xor(v, o);
    return v;
}
__host__ __device__ __forceinline__ int qkv_slot_of_col(int n) { const int t = n >> 8, c = n & 255, wc = c >> 6, bj = (c >> 5) & 1, j = c & 31; return (t << 8) + 128 * bj + 32 * wc + j; }

template <bool PERMQ> __device__ __forceinline__ void p0_transpose_item(const float* W, int K, int N, bf16_t* WT, LAS float* scr, int item, int lane) {
    const int nblk = N / 32, kb = item / nblk, nb = item % nblk, k0 = 64 * kb, n0 = 32 * nb;
#pragma unroll 8
    for (int i = 0; i < 32; ++i) { const int kk = 2 * i + (lane >> 5); scr[kk * 33 + (lane & 31)] = W[(size_t)(k0 + kk) * N + n0 + (lane & 31)]; }
    LDS_WAIT(); asm volatile("" ::: "memory");
    const int c = lane & 7;
#pragma unroll
    for (int j = 0; j < 4; ++j) { const int n = (lane >> 3) + 8 * j; const LAS float* s = scr + (8 * c) * 33 + n;
        v4u o; o.x = pk2(s[0 * 33], s[1 * 33]); o.y = pk2(s[2 * 33], s[3 * 33]); o.z = pk2(s[4 * 33], s[5 * 33]); o.w = pk2(s[6 * 33], s[7 * 33]);
        const int nd = PERMQ ? qkv_slot_of_col(n0 + n) : (n0 + n);
        *(GAS v4u*)(WT + (size_t)nd * K + k0 + 8 * c) = o; }
    LDS_WAIT(); asm volatile("" ::: "memory");
}

__device__ __forceinline__ void p0_prologue(Frame& F, const Args& a) {
    unsigned char* ws = a.ws;
    if (F.vcu < 192) {
        LAS float* s = (LAS float*)(F.lds);
        LAS float* part = (LAS float*)(F.lds + 9 * 1024 * 4);
        const float* c = a.in[1]; const float* c_ctx = a.in[3];
        for (int i = F.tid; i < 9 * 1024; i += 512) { const int r = i >> 10, k = i & 1023; s[i] = silu(r < 8 ? c[r * 1024 + k] : c_ctx[k]); }
        __syncthreads();
        const int l = F.vcu / 96, n0 = (F.vcu % 96) * 64;
        const float* w = a.in[6] + (size_t)l * 1024 * 6144 + n0 + F.lane;
        float acc[9];
#pragma unroll
        for (int r = 0; r < 9; ++r) acc[r] = 0.f;
        const int kb = F.wave * 128;
#pragma unroll 16
        for (int k = 0; k < 128; ++k) { const float wv = w[(size_t)(kb + k) * 6144];
#pragma unroll
            for (int r = 0; r < 9; ++r) acc[r] += s[r * 1024 + kb + k] * wv; }
#pragma unroll
        for (int r = 0; r < 9; ++r) part[(F.wave * 9 + r) * 64 + F.lane] = acc[r];
        __syncthreads();
        float* modv = (float*)(ws + WS_MODV);
        for (int i = F.tid; i < 9 * 64; i += 512) { const int r = i >> 6, n = i & 63; float v = a.in[7][l * 6144 + n0 + n];
#pragma unroll
            for (int wv = 0; wv < 8; ++wv) v += part[(wv * 9 + r) * 64 + n];
            modv[((size_t)l * 9 + r) * 6144 + n0 + n] = v; }
        __syncthreads();
    } else {
        const int t0 = (F.vcu - 192) * 512 + F.tid;
        float* rope = (float*)(ws + WS_ROPE);
        for (int i = t0; i < 2048 * 32; i += 64 * 512) { const int t = i >> 5, k = i & 31, f = k & 15;
            const float inv = powf(10000.f, -(float)f / 16.f); const float pos = (k < 16) ? (float)(t >> 6) : (float)(t & 63); const float ang = pos * inv;
            rope[i] = cosf(ang); rope[2048 * 32 + i] = sinf(ang); }
        if (t0 < 2 * 64 * 64) { const int i = t0, dg = i >> 6;
            const float lr = a.in[23][i], li = a.in[24][i], dt = expf(a.in[25][dg]);
            const float mag = expf(lr * dt), ar = mag * cosf(li * dt), ai = mag * sinf(li * dt);
            const float den = lr * lr + li * li, nr = ar - 1.f;
            const float fr = (nr * lr + ai * li) / den, fi = (ai * lr - nr * li) / den;
            float* ab = (float*)(ws + WS_S5AB); float* bb = (float*)(ws + WS_S5BB);
            ab[2 * i] = ar; ab[2 * i + 1] = ai;
            { float pr = ar, pi = ai; for (int q = 0; q < 7; ++q) { const float t = pr * pr - pi * pi; pi = 2.f * pr * pi; pr = t; } float* ap = (float*)(ws + 2 * MiB + 128 * 1024); ap[2 * i] = pr; ap[2 * i + 1] = pi; }
            for (int h = 0; h < 16; ++h) { const float br = a.in[26][(size_t)i * 16 + h], bi = a.in[27][(size_t)i * 16 + h];
                bb[(size_t)i * 16 + h] = fr * br - fi * bi; bb[(size_t)2 * 64 * 64 * 16 + (size_t)i * 16 + h] = fr * bi + fi * br; } }
        if (t0 == 0) { float s1 = 0.f, s2 = 0.f; for (int i = 0; i < 64; ++i) { s1 += a.in[17][i] * a.in[18][i]; s2 += a.in[19][i] * a.in[20][i]; }
            ((float*)(ws + WS_LAM))[0] = expf(s1) - expf(s2) + LAMBDA_INIT0; }
    }
    LAS float* scr = (LAS float*)(F.lds + RING_OFF + F.wave * 16384);
    const int gw = F.vcu * NWAVES + F.wave, NGW = F.G * NWAVES;
    constexpr int I_QKV = (D / 64) * (ZW / 32), I_SQ = (D / 64) * (D / 32), I_1 = (D / 64) * (FF / 32), I_2 = (FF / 64) * (D / 32);
    constexpr int NITEMS = I_QKV + I_SQ + 2 * I_1 + 2 * I_2 + 3 * I_SQ;
    for (int it = gw; it < NITEMS; it += NGW) {
        int r = it;
        if (r < I_QKV) { p0_transpose_item<true>(a.in[10], D, ZW, (bf16_t*)(ws + WS_WQKV), scr, r, F.lane); continue; } r -= I_QKV;
        if (r < I_SQ) { p0_transpose_item<false>(a.in[11], D, D, (bf16_t*)(ws + WS_WO), scr, r, F.lane); continue; } r -= I_SQ;
        if (r < I_1) { p0_transpose_item<false>(a.in[8], D, FF, (bf16_t*)(ws + WS_W1), scr, r, F.lane); continue; } r -= I_1;
        if (r < I_1) { p0_transpose_item<false>(a.in[8] + (size_t)D * FF, D, FF, (bf16_t*)(ws + WS_W1) + (size_t)D * FF, scr, r, F.lane); continue; } r -= I_1;
        if (r < I_2) { p0_transpose_item<false>(a.in[9], FF, D, (bf16_t*)(ws + WS_W2), scr, r, F.lane); continue; } r -= I_2;
        if (r < I_2) { p0_transpose_item<false>(a.in[9] + (size_t)D * FF, FF, D, (bf16_t*)(ws + WS_W2) + (size_t)D * FF, scr, r, F.lane); continue; } r -= I_2;
        if (r < I_SQ) { p0_transpose_item<false>(a.in[22], D, D, (bf16_t*)(ws + WS_WS5IN), scr, r, F.lane); continue; } r -= I_SQ;
        if (r < I_SQ) { p0_transpose_item<false>(a.in[31], D, D, (bf16_t*)(ws + WS_WGLU), scr, r, F.lane); continue; } r -= I_SQ;
        p0_transpose_item<false>(a.in[33], D, D, (bf16_t*)(ws + WS_WS5OUT), scr, r, F.lane);
    }
}
__device__ __forceinline__ void norm_mod_phase(Frame& F, const float* src_lat, const float* src_ctx, const float* g, const float* modv_l, int shift_idx, int scale_idx, bf16_t* out, int nrows) {
    const int gw = F.vcu * NWAVES + F.wave, NGW = F.G * NWAVES;
    for (int r = gw; r < nrows; r += NGW) {
        const float* x = r < ML ? src_lat + (size_t)r * D : src_ctx + (size_t)(r - ML) * D;
        const float* mv = modv_l + (size_t)(r < ML ? (r >> 11) : 8) * 6144;
        const GAS f32x4* xr = (const GAS f32x4*)x + F.lane;
        f32x4 v[4]; float s = 0.f;
#pragma unroll
        for (int j = 0; j < 4; ++j) { v[j] = xr[64 * j]; s += (v[j].x * v[j].x + v[j].y * v[j].y) + (v[j].z * v[j].z + v[j].w * v[j].w); }
        const float rstd = 1.f / sqrtf(wave_sum(s) * (1.f / D) + EPS);
        GAS unsigned long long* o8 = (GAS unsigned long long*)(out + (size_t)r * D) + F.lane;
#pragma unroll
        for (int j = 0; j < 4; ++j) { const int col = 4 * F.lane + 256 * j;
            const f32x4 gg = *(const f32x4*)(g + col), sc = *(const f32x4*)(mv + scale_idx * 1024 + col), sh = *(const f32x4*)(mv + shift_idx * 1024 + col);
            const f32x4 y = v[j] * rstd * gg * (sc + 1.f) + sh;
            o8[64 * j] = (unsigned long long)pk2(y.x, y.y) | ((unsigned long long)pk2(y.z, y.w) << 32); }
    }
}
namespace att {
typedef short bf16x8 __attribute__((ext_vector_type(8)));
typedef short s16x4 __attribute__((ext_vector_type(4)));
typedef float f32x16 __attribute__((ext_vector_type(16)));
typedef unsigned u32x4 __attribute__((ext_vector_type(4)));
typedef short v4i16_t __attribute__((ext_vector_type(4)));
typedef float f32x2_t __attribute__((ext_vector_type(2))); typedef __bf16 bf16x2_t __attribute__((ext_vector_type(2)));
__device__ __forceinline__ int crow(int r, int hi) { return (r & 3) + 8 * (r >> 2) + 4 * hi; }
__device__ __forceinline__ unsigned cvtpk(float lo, float hi) { f32x2_t v = {lo, hi}; bf16x2_t b = __builtin_convertvector(v, bf16x2_t); return __builtin_bit_cast(unsigned, b); }
constexpr int KB = 8192;
constexpr int BUFB = KB + 16384;
constexpr int OFF_WS = 2 * BUFB;
constexpr int OFF_ST = OFF_WS + 8 * 256;
constexpr int LDS_NEED = OFF_ST + 8 * 8192;
typedef __attribute__((address_space(3))) unsigned char* ldsp;

struct Tiles {
    int n1, nt, nmask; long base1, base2; int kpos0;
};
template <int DV> __device__ __forceinline__ void run(ldsp lds, const bf16_t* Z, long qrow0  , int qcol, int kcol, int vcol, const Tiles T, int qpos0  ,
                                                      float mref, f32x16 (&o)[DV / 32], float& lsum, int tid) {
    const int lane = tid & 63, r32 = lane & 31, hi = lane >> 5;
    bf16x8 qr[4];
#pragma unroll
    for (int d0 = 0; d0 < 4; ++d0) qr[d0] = *(const bf16x8*)(Z + (qrow0 + r32) * ZW + qcol + d0 * 16 + hi * 8);
#pragma unroll
    for (int i = 0; i < DV / 32; ++i) o[i] = f32x16{};
    const f32x16 zero16 = f32x16{};
    float l = 0.f;
    const int kkey = tid & 63, kch = tid >> 6;
    u32x4 kreg; u32x4 vreg[DV / 64];
#define ATT_LOAD(t) do { const long kr_ = (t) < T.n1 ? T.base1 + 64 * (t) : T.base2 + 64 * ((t) - T.n1); kreg = *(const u32x4*)(Z + (kr_ + kkey) * ZW + kcol + kch * 8); \
        _Pragma("unroll") for (int i_ = 0; i_ < DV / 64; ++i_) { const int idx_ = tid + 512 * i_; const int key_ = DV == 128 ? (idx_ >> 4) : (idx_ >> 3), pc_ = DV == 128 ? (idx_ & 15) : (idx_ & 7); \
            vreg[i_] = *(const u32x4*)(Z + (kr_ + key_) * ZW + vcol + pc_ * 8); } } while (0)
#define ATT_STORE(buf) do { *(__attribute__((address_space(3))) u32x4*)(lds + (buf) * BUFB + kch * 1024 + kkey * 16) = kreg; \
        _Pragma("unroll") for (int i_ = 0; i_ < DV / 64; ++i_) { const int idx_ = tid + 512 * i_; const int key_ = DV == 128 ? (idx_ >> 4) : (idx_ >> 3), pc_ = DV == 128 ? (idx_ & 15) : (idx_ & 7); \
            *(__attribute__((address_space(3))) u32x4*)(lds + (buf) * BUFB + KB + (pc_ >> 2) * 4096 + key_ * 64 + (pc_ & 3) * 16) = vreg[i_]; } } while (0)
    ATT_LOAD(0); ATT_STORE(0);
    __syncthreads();
    for (int t = 0; t < T.nt; ++t) {
        const int buf = t & 1;
        if (t + 1 < T.nt) ATT_LOAD(t + 1);
        f32x16 p0, p1;
        { const ldsp kb = lds + buf * BUFB + hi * 1024 + r32 * 16;
#pragma unroll
          for (int d0 = 0; d0 < 4; ++d0) {
              const bf16x8 b0 = *(const __attribute__((address_space(3))) bf16x8*)(kb + d0 * 2048);
              const bf16x8 b1 = *(const __attribute__((address_space(3))) bf16x8*)(kb + d0 * 2048 + 512);
              if (d0 == 0) { p0 = __builtin_amdgcn_mfma_f32_32x32x16_bf16(b0, qr[0], zero16, 0, 0, 0); p1 = __builtin_amdgcn_mfma_f32_32x32x16_bf16(b1, qr[0], zero16, 0, 0, 0); }
              else { p0 = __builtin_amdgcn_mfma_f32_32x32x16_bf16(b0, qr[d0], p0, 0, 0, 0); p1 = __builtin_amdgcn_mfma_f32_32x32x16_bf16(b1, qr[d0], p1, 0, 0, 0); } } }
#pragma unroll
        for (int r = 0; r < 16; ++r) { p0[r] = __builtin_amdgcn_exp2f(p0[r] - mref); p1[r] = __builtin_amdgcn_exp2f(p1[r] - mref); }
        if (t < T.nmask) { const int qp = qpos0 + r32; const int kb0 = T.kpos0 + 64 * t;
#pragma unroll
            for (int r = 0; r < 16; ++r) { const int k0 = kb0 + crow(r, hi), dd0 = k0 - qp, dd1 = dd0 + 32;
                if (dd0 > 128 || dd0 < -128) p0[r] = 0.f;
                if (dd1 > 128 || dd1 < -128) p1[r] = 0.f; } }
        { float s = 0.f;
#pragma unroll
          for (int r = 0; r < 16; ++r) s += p0[r] + p1[r];
          l += s; }
        __builtin_amdgcn_sched_barrier(0);
        u32x4 pw[4];
#pragma unroll
        for (int i = 0; i < 4; ++i) { pw[0][i] = cvtpk(p0[2 * i], p0[2 * i + 1]); pw[1][i] = cvtpk(p0[8 + 2 * i], p0[8 + 2 * i + 1]); pw[2][i] = cvtpk(p1[2 * i], p1[2 * i + 1]); pw[3][i] = cvtpk(p1[8 + 2 * i], p1[8 + 2 * i + 1]); }
        __builtin_amdgcn_sched_barrier(0);
        { const ldsp vp = lds + buf * BUFB + KB + ((lane >> 4) & 1) * 32 + (lane & 3) * 8 + (4 * hi + ((lane & 15) >> 2)) * 64;
#pragma unroll
          for (int d0 = 0; d0 < DV / 32; ++d0) {
#pragma unroll
              for (int ks = 0; ks < 4; ++ks) {
                  const s16x4 lo = __builtin_bit_cast(s16x4, __builtin_amdgcn_ds_read_tr16_b64_v4i16((__attribute__((address_space(3))) v4i16_t*)(vp + d0 * 4096 + ks * 1024)));
                  const s16x4 hh = __builtin_bit_cast(s16x4, __builtin_amdgcn_ds_read_tr16_b64_v4i16((__attribute__((address_space(3))) v4i16_t*)(vp + d0 * 4096 + ks * 1024 + 512)));
                  const bf16x8 vf = (bf16x8){lo[0], lo[1], lo[2], lo[3], hh[0], hh[1], hh[2], hh[3]};
                  o[d0] = __builtin_amdgcn_mfma_f32_32x32x16_bf16(__builtin_bit_cast(bf16x8, pw[ks]), vf, o[d0], 0, 0, 0); }
              __builtin_amdgcn_sched_barrier(0); } }
        if (t + 1 < T.nt) ATT_STORE(buf ^ 1);
        __syncthreads();
    }
#undef ATT_LOAD
#undef ATT_STORE
    l += __shfl_xor(l, 32);
    lsum = l;
}
__device__ __forceinline__ void rl_table(ldsp lds, int wave, int lane, float l, float (&rli)[16]) {
    __attribute__((address_space(3))) float* wsf = (__attribute__((address_space(3))) float*)(lds + OFF_WS + wave * 256);
    const int r32 = lane & 31, hi = lane >> 5;
    if (hi == 0) wsf[r32] = l;
    asm volatile("s_waitcnt lgkmcnt(0)" ::: "memory");
#pragma unroll
    for (int r = 0; r < 16; ++r) rli[r] = 1.f / wsf[crow(r, hi)];
    asm volatile("s_waitcnt lgkmcnt(0)" ::: "memory");
}
template <int NB  > __device__ __forceinline__ void store_rows(ldsp lds, int wave, int lane, const f32x16 (&v)[NB], bf16_t* dst) {
    __attribute__((address_space(3))) bf16_t* stg = (__attribute__((address_space(3))) bf16_t*)(lds + OFF_ST + wave * 8192);
    const int r32 = lane & 31, hi = lane >> 5;
#pragma unroll
    for (int r = 0; r < 16; ++r) { const int orow = crow(r, hi);
#pragma unroll
        for (int d0 = 0; d0 < NB; ++d0) stg[orow * (NB * 32) + d0 * 32 + r32] = f2bf(v[d0][r]); }
    asm volatile("s_waitcnt lgkmcnt(0)" ::: "memory");
    constexpr int CPR = NB * 4;
#pragma unroll
    for (int i = 0; i < (32 * CPR) / 64; ++i) { const int idx = i * 64 + lane, row = idx / CPR, ch = idx % CPR;
        const u32x4 w = *(const __attribute__((address_space(3))) u32x4*)(stg + row * (NB * 32) + ch * 8);
        *(u32x4*)(dst + (size_t)row * D + ch * 8) = w; }
    asm volatile("s_waitcnt lgkmcnt(0)" ::: "memory");
}
}

constexpr int ATT_ITEMS = 256 + 512 + 64 + 32;
__device__ __forceinline__ void attn_phase(Frame& F, const Args& a, unsigned qidx) {
    using namespace att;
    ldsp lds = (ldsp)F.lds;
    unsigned char* ws = a.ws;
    const bf16_t* Z = (const bf16_t*)(ws + WS_Z); bf16_t* O = (bf16_t*)(ws + WS_O); float* scr = (float*)(ws + WS_A);
    const int wave = F.wave;
    float gaq = 0.f, gak = 0.f, gbq = 0.f, gbk = 0.f;
    { const int lane = F.lane; gaq = fabsf(a.in[12][lane]); gak = fabsf(a.in[13][lane]); gbq = fabsf(a.in[15][lane]); gbk = fabsf(a.in[16][lane]);
#pragma unroll
      for (int o_ = 1; o_ < 64; o_ <<= 1) { gaq = fmaxf(gaq, __shfl_xor(gaq, o_)); gak = fmaxf(gak, __shfl_xor(gak, o_)); gbq = fmaxf(gbq, __shfl_xor(gbq, o_)); gbk = fmaxf(gbk, __shfl_xor(gbk, o_)); } }
    const float mrefA0 = 64.f * C2 * gaq * gak * 1.02f, mrefB = 64.f * C2 * gbq * gbk * 1.02f;
    const float lam = ((const float*)(ws + WS_LAM))[0];
    gu32* qhead = F.ctl + CW_QUEUE + 64 * qidx;
    for (;;) {
        if (F.tid == 0) F.MISC[16] = __hip_atomic_fetch_add(qhead, 1u, RLX_AGENT);
        __syncthreads();
        const int item = (int)F.MISC[16];
        __syncthreads();
        if (item >= ATT_ITEMS) break;
        int tid = F.tid; asm volatile("" : "+v"(tid));
        const int lane = tid & 63, r32 = lane & 31;
        if (item < 256 || item >= 832) {
            const bool latq = item < 256; int b, h, qb;
            if (latq) { b = item >> 5; h = (item >> 3) & 3; qb = item & 7; } else { const int j = item - 832; b = j >> 2; h = j & 3; qb = 0; }
            const long qrow0 = (latq ? (long)b * 2048 + qb * 256 : (long)ML + b * 256) + wave * 32;
            Tiles T; T.n1 = 4; T.nt = latq ? 36 : 4; T.nmask = 0; T.base1 = (long)ML + b * 256; T.base2 = (long)b * 2048; T.kpos0 = 0;
            f32x16 o[4]; float l1, l2; float rli[16];
            run<128>(lds, Z, qrow0, ZQB + h * 128, ZKB + h * 128, ZVB + h * 128, T, 0, mrefB, o, l1, tid);
            rl_table(lds, wave, lane, l1, rli);
            float* sp = scr + ((size_t)(blockIdx.x * 8 + wave) * 64 + lane) * 64;
#pragma unroll
            for (int d0 = 0; d0 < 4; ++d0)
#pragma unroll
                for (int r = 0; r < 16; r += 4) *(f32x4*)(sp + d0 * 16 + r) = (f32x4){o[d0][r] * rli[r], o[d0][r + 1] * rli[r + 1], o[d0][r + 2] * rli[r + 2], o[d0][r + 3] * rli[r + 3]};
            run<128>(lds, Z, qrow0, ZQB + h * 128 + 64, ZKB + h * 128 + 64, ZVB + h * 128, T, 0, mrefB, o, l2, tid);
            rl_table(lds, wave, lane, l2, rli);
            float ss[16];
#pragma unroll
            for (int r = 0; r < 16; ++r) ss[r] = 0.f;
#pragma unroll
            for (int d0 = 0; d0 < 4; ++d0) {
#pragma unroll
                for (int r = 0; r < 16; r += 4) { const f32x4 s1 = *(const f32x4*)(sp + d0 * 16 + r);
#pragma unroll
                    for (int e = 0; e < 4; ++e) { const float w = s1[e] - lam * o[d0][r + e] * rli[r + e]; o[d0][r + e] = w; ss[r + e] += w * w; } }
                asm volatile("" ::: "memory"); }
#pragma unroll
            for (int r = 0; r < 16; ++r) {
#pragma unroll
                for (int o_ = 1; o_ < 32; o_ <<= 1) ss[r] += __shfl_xor(ss[r], o_);
                ss[r] = (1.f - LAMBDA_INIT0) / sqrtf(ss[r] * (1.f / 128.f) + EPS); }
#pragma unroll
            for (int d0 = 0; d0 < 4; ++d0) { const float sg = a.in[21][d0 * 32 + r32];
#pragma unroll
                for (int r = 0; r < 16; ++r) o[d0][r] *= ss[r] * sg; }
            store_rows<4>(lds, wave, lane, o, O + (size_t)qrow0 * D + 512 + h * 128);
        } else {
            const bool latq = item < 768; int b, kvh, qb;
            if (latq) { const int j = item - 256; b = j >> 6; kvh = (j >> 5) & 1; qb = j & 31; } else { const int j = item - 768; b = j >> 3; kvh = (j >> 2) & 1; qb = j & 3; }
            const int head = kvh * 4 + (wave >> 1);
            const int qpos0 = qb * 64 + (wave & 1) * 32;
            const long qrow0 = (latq ? (long)b * 2048 : (long)ML + b * 256) + qpos0;
            Tiles T;
            if (latq) { int ws0 = qb * 64 - 128, we = qb * 64 + 192; if (ws0 < 0) ws0 = 0; if (we > 2048) we = 2048;
                T.n1 = (we - ws0) / 64; T.nt = T.n1 + 4; T.nmask = T.n1; T.base1 = (long)b * 2048 + ws0; T.base2 = (long)ML + b * 256; T.kpos0 = ws0; }
            else { T.n1 = 4; T.nt = 4; T.nmask = 0; T.base1 = (long)ML + b * 256; T.base2 = T.base1; T.kpos0 = 0; }
            const float sk = a.in[14][head] * LOG2E; const float mrefA = fmaxf(mrefA0, sk);
            f32x16 o[2]; float l; float rli[16];
            run<64>(lds, Z, qrow0, ZQA + head * 64, ZKA + kvh * 64, ZVA + kvh * 64, T, qpos0, mrefA, o, l, tid);
            l += __builtin_amdgcn_exp2f(sk - mrefA);
            rl_table(lds, wave, lane, l, rli);
#pragma unroll
            for (int d0 = 0; d0 < 2; ++d0)
#pragma unroll
                for (int r = 0; r < 16; ++r) o[d0][r] *= rli[r];
            store_rows<2>(lds, wave, lane, o, O + (size_t)qrow0 * D + head * 64);
        }
    }
}
namespace s5 {
typedef short bf16x8 __attribute__((ext_vector_type(8)));
typedef short s16x4 __attribute__((ext_vector_type(4)));
typedef float f32x16 __attribute__((ext_vector_type(16)));
typedef float f32x4 __attribute__((ext_vector_type(4)));
typedef unsigned u32x4 __attribute__((ext_vector_type(4)));
typedef unsigned u32x2 __attribute__((ext_vector_type(2)));
typedef short v4i16_t __attribute__((ext_vector_type(4)));
typedef __attribute__((address_space(3))) unsigned char* ldsp;
constexpr int LC = 128, NCH = 18, NSTEP = LC / 16;
constexpr size_t WS_E = 244 * MiB;
constexpr size_t WS_S5AP = 2 * MiB + 128 * 1024;
__device__ __forceinline__ unsigned pkbf(float lo, float hi) { return (unsigned)f2bf(lo) | ((unsigned)f2bf(hi) << 16); }
__device__ __forceinline__ bf16x8 pack8(const f32x4 a, const f32x4 b) { u32x4 w; w.x = pkbf(a[0], a[1]); w.y = pkbf(a[2], a[3]); w.z = pkbf(b[0], b[1]); w.w = pkbf(b[2], b[3]); return __builtin_bit_cast(bf16x8, w); }
__device__ __forceinline__ long seq_row(int dir, int b, int s) {
    if (s < 256) return (long)ML + b * 256 + (dir == 0 ? s : 255 - s);
    return (long)b * 2048 + (dir == 0 ? s - 256 : 2047 - (s - 256));
}
struct Ctx { const bf16_t* U; const float* ab; const float* ap; const float* bb; const float* c_re; const float* c_im; const float* dskip; float* E; bf16_t* G; float* scr; };

template <bool READOUT, int DIRT> __device__ __forceinline__ void chunk_run(const Ctx& C, ldsp hl  , float* sp  , int g, int dir_rt, int bp, int c, int lane,
                                                                  float (&hr)[2], float (&hi)[2]) {
    const int dir = DIRT >= 0 ? DIRT : dir_rt;
    const int l31 = lane & 31, hh = lane >> 5;
    const int dg = dir * 64 + g;
    bf16x8 bre[2], bim[2]; float ar[2], ai[2];
#pragma unroll
    for (int blk = 0; blk < 2; ++blk) { const size_t i = (size_t)dg * 64 + 32 * blk + l31;
        const f32x4* pr = (const f32x4*)(C.bb + i * 16 + 8 * hh); const f32x4* pi = (const f32x4*)(C.bb + (size_t)2 * 64 * 64 * 16 + i * 16 + 8 * hh);
        bre[blk] = pack8(pr[0], pr[1]); bim[blk] = pack8(pi[0], pi[1]);
        ar[blk] = C.ab[2 * i]; ai[blk] = C.ab[2 * i + 1]; }
    bf16x8 cm[8];
    if (READOUT) {
#pragma unroll
        for (int s = 0; s < 8; ++s) { f32x4 x0 = (f32x4){0.f, 0.f, 0.f, 0.f}, x1 = x0;
            if (l31 < 16) { const float* src = (s < 4 ? C.c_re : C.c_im) + ((size_t)dg * 16 + l31) * 64 + 16 * (s & 3) + 8 * hh; x0 = *(const f32x4*)src; x1 = *(const f32x4*)(src + 4); if (s >= 4) { x0 = -x0; x1 = -x1; } }
            cm[s] = pack8(x0, x1); } }
    const int b = 2 * bp + hh;
    const int a_b = 2 * bp + ((l31 >> 2) & 1), a_idx = (l31 & 3) + 4 * (l31 >> 3);
    const f32x16 zero16 = f32x16{};
#pragma unroll 1
    for (int st = 0; st < NSTEP; ++st) {
        const int s0 = c * LC + st * 16;
        const long arow = seq_row(dir, a_b, s0 + a_idx);
        const bf16x8 uf = *(const bf16x8*)(C.U + arow * D + g * 16 + 8 * hh);
        f32x16 xr[2], xi[2];
#pragma unroll
        for (int blk = 0; blk < 2; ++blk) { xr[blk] = __builtin_amdgcn_mfma_f32_32x32x16_bf16(uf, bre[blk], zero16, 0, 0, 0); xi[blk] = __builtin_amdgcn_mfma_f32_32x32x16_bf16(uf, bim[blk], zero16, 0, 0, 0); }
#pragma unroll
        for (int r = 0; r < 16; ++r)
#pragma unroll
            for (int blk = 0; blk < 2; ++blk) { const float nr = ar[blk] * hr[blk] - ai[blk] * hi[blk] + xr[blk][r], ni = ar[blk] * hi[blk] + ai[blk] * hr[blk] + xi[blk][r];
                hr[blk] = nr; hi[blk] = ni; xr[blk][r] = nr; xi[blk][r] = ni; }
        if (READOUT) {
#pragma unroll
            for (int blk = 0; blk < 2; ++blk)
#pragma unroll
                for (int part = 0; part < 2; ++part) { u32x4 w0, w1;
#pragma unroll
                    for (int w = 0; w < 8; ++w) { const int ra = DIRT == 0 ? 2 * w : 15 - 2 * w, rb = DIRT == 0 ? 2 * w + 1 : 14 - 2 * w;
                        const float va = part == 0 ? xr[blk][ra] : xi[blk][ra], vb = part == 0 ? xr[blk][rb] : xi[blk][rb];
                        if (w < 4) w0[w] = pkbf(va, vb); else w1[w - 4] = pkbf(va, vb); }
                    const ldsp dst = hl + (part * 64 + 32 * blk + l31) * 64 + 32 * hh;
                    *(__attribute__((address_space(3))) u32x4*)dst = w0; *(__attribute__((address_space(3))) u32x4*)(dst + 16) = w1; }
            asm volatile("s_waitcnt lgkmcnt(0)" ::: "memory");
            f32x16 y = zero16;
            const ldsp vp = hl + ((lane >> 4) & 1) * 32 + (lane & 3) * 8 + (8 * hh + ((lane & 15) >> 2)) * 64;
#pragma unroll
            for (int s = 0; s < 8; ++s) {
                const s16x4 lo = __builtin_bit_cast(s16x4, __builtin_amdgcn_ds_read_tr16_b64_v4i16((__attribute__((address_space(3))) v4i16_t*)(vp + s * 1024)));
                const s16x4 h4 = __builtin_bit_cast(s16x4, __builtin_amdgcn_ds_read_tr16_b64_v4i16((__attribute__((address_space(3))) v4i16_t*)(vp + s * 1024 + 256)));
                const bf16x8 hf = (bf16x8){lo[0], lo[1], lo[2], lo[3], h4[0], h4[1], h4[2], h4[3]};
                y = __builtin_amdgcn_mfma_f32_32x32x16_bf16(cm[s], hf, y, 0, 0, 0); }
            asm volatile("s_waitcnt lgkmcnt(0)" ::: "memory");
            const int n = l31, yb = 2 * bp + (n >> 4);
            const int tok0 = dir == 0 ? (s0 - 256) : (2047 - (s0 - 256) - 15);
            const int kf = (tok0 & (LC - 1)) >> 4;
            if (dir == 0) { *(f32x4*)(sp + kf * 8) = (f32x4){y[0], y[1], y[2], y[3]}; *(f32x4*)(sp + kf * 8 + 4) = (f32x4){y[4], y[5], y[6], y[7]}; }
            else { const f32x4 f0 = *(const f32x4*)(sp + kf * 8), f1 = *(const f32x4*)(sp + kf * 8 + 4);
                const long row = (long)yb * 2048 + tok0 + (n & 15);
#pragma unroll
                for (int q = 0; q < 2; ++q) { const int ch = g * 16 + 8 * q + 4 * hh;
                    const u32x2 uu = *(const u32x2*)(C.U + row * D + ch); const f32x4 dv = *(const f32x4*)(C.dskip + ch);
                    float o4[4];
#pragma unroll
                    for (int e = 0; e < 4; ++e) { const unsigned wd = uu[e >> 1]; const float uval = __builtin_bit_cast(float, (e & 1) ? (wd & 0xffff0000u) : (wd << 16));
                        const float v = (q == 0 ? f0[e] : f1[e]) + y[4 * q + e] + uval * dv[e];
                        const float t = 0.7978845608028654f * (v + 0.044715f * v * v * v); o4[e] = v * __builtin_amdgcn_rcpf(1.f + __expf(-2.f * t)); }
                    u32x2 ow; ow.x = pkbf(o4[0], o4[1]); ow.y = pkbf(o4[2], o4[3]);
                    *(u32x2*)(C.G + row * D + ch) = ow; } }
        }
    }
    (void)b;
}
}

__device__ __forceinline__ void s5_pass_a(Frame& F, const s5::Ctx& C) {
    const int gw = F.vcu * NWAVES + F.wave, NGW = F.G * NWAVES;
    constexpr int NU = 64 * 2 * 4 * 17;
    for (int u = gw; u < NU; u += NGW) {
        int lane = F.lane; asm volatile("" : "+v"(lane));
        const int c = u % 17, bp = (u / 17) & 3, dir = (u / 68) & 1, g = u / 136;
        float hr[2] = {0.f, 0.f}, hi[2] = {0.f, 0.f};
        s5::chunk_run<false, -1>(C, (s5::ldsp)nullptr, nullptr, g, dir, bp, c, lane, hr, hi);
        const int b = 2 * bp + (lane >> 5);
        float* e = C.E + ((((size_t)(dir * 64 + g) * 8 + b) * s5::NCH + c) * 2) * 64 + (lane & 31);
#pragma unroll
        for (int blk = 0; blk < 2; ++blk) { e[32 * blk] = hr[blk]; e[64 + 32 * blk] = hi[blk]; }
    }
}
__device__ __forceinline__ void s5_pass_b(Frame& F, const s5::Ctx& C) {
    const int gw = F.vcu * NWAVES + F.wave, NGW = F.G * NWAVES;
    constexpr int NU = 64 * 4 * 16;
    const s5::ldsp hl = (s5::ldsp)F.lds + F.wave * 8192;
    for (int u = gw; u < NU; u += NGW) {
        int lane = F.lane; asm volatile("" : "+v"(lane));
        const int lc = u & 15, bp = (u >> 4) & 3, g = u >> 6;
        float* sp = C.scr + ((size_t)(blockIdx.x * 8 + F.wave) * 64 + lane) * 64;
        const int b = 2 * bp + (lane >> 5);
#pragma unroll
        for (int dir = 0; dir < 2; ++dir) {
            const int c = dir == 0 ? 2 + lc : 2 + (15 - lc);
            float hr[2] = {0.f, 0.f}, hi[2] = {0.f, 0.f}, pr[2], pi[2];
#pragma unroll
            for (int blk = 0; blk < 2; ++blk) { const size_t i = (size_t)(dir * 64 + g) * 64 + 32 * blk + (lane & 31); pr[blk] = C.ap[2 * i]; pi[blk] = C.ap[2 * i + 1]; }
            const float* e0 = C.E + (((size_t)(dir * 64 + g) * 8 + b) * s5::NCH * 2) * 64 + (lane & 31);
#pragma unroll 1
            for (int cc = 0; cc < c; ++cc) {
#pragma unroll
                for (int blk = 0; blk < 2; ++blk) { const float er = e0[(size_t)cc * 128 + 32 * blk], ei = e0[(size_t)cc * 128 + 64 + 32 * blk];
                    const float nr = pr[blk] * hr[blk] - pi[blk] * hi[blk] + er, ni = pr[blk] * hi[blk] + pi[blk] * hr[blk] + ei; hr[blk] = nr; hi[blk] = ni; } }
            if (dir == 0) s5::chunk_run<true, 0>(C, hl, sp, g, 0, bp, c, lane, hr, hi);
            else s5::chunk_run<true, 1>(C, hl, sp, g, 1, bp, c, lane, hr, hi);
        }
    }
}
#ifndef QKV_FUSE
#define QKV_FUSE true
#endif
__global__ void __launch_bounds__(NWAVES * 64, 2) mega(Args args) {
    extern __shared__ __attribute__((aligned(16))) unsigned char lds[];
    Frame F;
    F.lds = (LAS unsigned char*)lds; F.MISC = (volatile LAS unsigned*)(F.lds + MISC_OFF);
    F.tid = threadIdx.x; F.lane = F.tid & 63; F.wave = __builtin_amdgcn_readfirstlane(F.tid >> 6);
    F.G = gridDim.x; { const int bx = blockIdx.x; F.vcu = (F.G % 8 == 0) ? (bx % 8) * (F.G / 8) + bx / 8 : bx; }
    unsigned char* ws = args.ws; F.ctl = (gu32*)(ws + WS_CTL);
    for (int u = F.tid; u < (LDS_BYTES - LDSCTL_OFF) / 4; u += NWAVES * 64) ((LAS unsigned*)(F.lds + LDSCTL_OFF))[u] = 0u;
    __syncthreads();
    const bool one_launch = (args.ph_hi - args.ph_lo) > 1;
    XcdBarrier bar; bar.bar = (unsigned*)(F.ctl + CW_BAR); bar.x = 0; bar.st = nullptr;
    if (one_launch) bar = xcd_barrier_post((unsigned*)(F.ctl + CW_BAR), F.MISC + 8);
    const int lo = args.ph_lo, hi = args.ph_hi;
#define IN(k) (lo <= (k) && (k) < hi)
#define SEAM(k) do { if (IN(k) && IN((k) + 1)) xcd_barrier(bar); } while (0)
    float* modv = (float*)(ws + WS_MODV); const float* modv0 = modv; const float* modv1 = modv + 9 * 6144;
    float* hctx = (float*)(ws + WS_HCTX); bf16_t* A = (bf16_t*)(ws + WS_A); bf16_t* Z = (bf16_t*)(ws + WS_Z); bf16_t* O = (bf16_t*)(ws + WS_O); bf16_t* U1 = (bf16_t*)(ws + WS_U1);
    bf16_t* U = (bf16_t*)(ws + WS_U); bf16_t* G = (bf16_t*)(ws + WS_G); bf16_t* G2 = (bf16_t*)(ws + WS_G2);
    const float* x = args.in[0]; const float* ctx = args.in[2]; float* out = args.out;
    constexpr int MLT = ML / 256;

    if (IN(0)) { p0_prologue(F, args); } SEAM(0);
    if (IN(1)) { norm_mod_phase(F, x, ctx, args.in[4], modv0, 0, 1, A, M); } SEAM(1);
    if (IN(2)) { pg8::Gemm g{A, (const bf16_t*)(ws + WS_WQKV), M, ZW, D}; pg8::StaticOrder S; S.init(M, ZW, F.G, (int)blockIdx.x);
        pg8::EpiQKV<QKV_FUSE> E{Z, args.in[12], args.in[13], args.in[15], args.in[16], (const float*)(ws + WS_ROPE), MLT};
        pg8::gemm_phase<pg8::EpiQKV<QKV_FUSE>, pg8::StaticOrder, true, true>(F.lds + RING_OFF, g, S, E); } SEAM(2);
    if (IN(3)) { attn_phase(F, args, 0); }
    SEAM(3);
    if (IN(4)) { pg8::Gemm g{O, (const bf16_t*)(ws + WS_WO), M, D, D}; pg8::StaticOrder S; S.init(M, D, F.G, (int)blockIdx.x);
        pg8::EpiResid E{x, ctx, out, hctx, modv0 + 2 * 1024, MLT};
        pg8::gemm_phase<pg8::EpiResid, pg8::StaticOrder, true, true>(F.lds + RING_OFF, g, S, E); } SEAM(4);
    if (IN(5)) { norm_mod_phase(F, out, hctx, args.in[5], modv0, 3, 4, A, M); } SEAM(5);
    if (IN(6)) { pg8::Gemm g{A, (const bf16_t*)(ws + WS_W1), M, FF, D}; pg8::StaticOrder S; S.init(M, FF, F.G, (int)blockIdx.x);
        pg8::EpiBf16<1> E{U1, FF};
        pg8::gemm_phase<pg8::EpiBf16<1>, pg8::StaticOrder, true, true>(F.lds + RING_OFF, g, S, E); } SEAM(6);
    if (IN(7)) { pg8::Gemm g{U1, (const bf16_t*)(ws + WS_W2), M, D, FF}; pg8::StaticOrder S; S.init(M, D, F.G, (int)blockIdx.x);
        pg8::EpiResid E{out, hctx, out, hctx, modv0 + 5 * 1024, MLT};
        pg8::gemm_phase<pg8::EpiResid, pg8::StaticOrder, true, true>(F.lds + RING_OFF, g, S, E); } SEAM(7);
    if (IN(8)) { norm_mod_phase(F, out, hctx, args.in[4] + D, modv1, 0, 1, A, M); } SEAM(8);
    if (IN(9)) { pg8::Gemm g{A, (const bf16_t*)(ws + WS_WS5IN), M, D, D}; pg8::StaticOrder S; S.init(M, D, F.G, (int)blockIdx.x);
        pg8::EpiBf16<0> E{U, D};
        pg8::gemm_phase<pg8::EpiBf16<0>, pg8::StaticOrder, true, true>(F.lds + RING_OFF, g, S, E); } SEAM(9);
    s5::Ctx SC{U, (const float*)(ws + WS_S5AB), (const float*)(ws + s5::WS_S5AP), (const float*)(ws + WS_S5BB), args.in[28], args.in[29], args.in[30], (float*)(ws + s5::WS_E), G, (float*)(ws + WS_YT)};
    if (IN(10)) { s5_pass_a(F, SC); } SEAM(10);
    if (IN(11)) { s5_pass_b(F, SC); } SEAM(11);
    if (IN(12)) { pg8::Gemm g{G, (const bf16_t*)(ws + WS_WGLU), ML, D, D}; pg8::StaticOrder S; S.init(ML, D, F.G, (int)blockIdx.x);
        pg8::EpiGlu E{G, G2, args.in[32]};
        pg8::gemm_phase<pg8::EpiGlu, pg8::StaticOrder, true, true>(F.lds + RING_OFF, g, S, E); } SEAM(12);
    if (IN(13)) { pg8::Gemm g{G2, (const bf16_t*)(ws + WS_WS5OUT), ML, D, D}; pg8::StaticOrder S; S.init(ML, D, F.G, (int)blockIdx.x);
        pg8::EpiResid E{out, hctx, out, hctx, modv1 + 2 * 1024, MLT};
        pg8::gemm_phase<pg8::EpiResid, pg8::StaticOrder, true, true>(F.lds + RING_OFF, g, S, E); } SEAM(13);
    if (IN(14)) { norm_mod_phase(F, out, hctx, args.in[5] + D, modv1, 3, 4, A, ML); } SEAM(14);
    if (IN(15)) { pg8::Gemm g{A, (const bf16_t*)(ws + WS_W1) + (size_t)D * FF, ML, FF, D}; pg8::StaticOrder S; S.init(ML, FF, F.G, (int)blockIdx.x);
        pg8::EpiBf16<1> E{U1, FF};
        pg8::gemm_phase<pg8::EpiBf16<1>, pg8::StaticOrder, true, true>(F.lds + RING_OFF, g, S, E); } SEAM(15);
    if (IN(16)) { pg8::Gemm g{U1, (const bf16_t*)(ws + WS_W2) + (size_t)D * FF, ML, D, FF}; pg8::StaticOrder S; S.init(ML, D, F.G, (int)blockIdx.x);
        pg8::EpiResid E{out, hctx, out, hctx, modv1 + 5 * 1024, MLT};
        pg8::gemm_phase<pg8::EpiResid, pg8::StaticOrder, true, true>(F.lds + RING_OFF, g, S, E); }
#undef IN
#undef SEAM
}

static int g_grid = 0;
static void launch_phases(const Args& base, int lo, int hi, hipStream_t stream) {
    Args a = base; a.ph_lo = lo; a.ph_hi = hi;
    hipLaunchKernelGGL(mega, dim3(g_grid), dim3(NWAVES * 64), LDS_BYTES, stream, a);
}
extern "C" void kernel_launch(void* const* d_in, const int* in_sizes, int n_in, void* d_out, int out_size, void* d_ws, size_t ws_size, hipStream_t stream) {
    (void)in_sizes; (void)out_size; (void)ws_size;
    if (g_grid == 0) {
        int dev = 0, cus = 0, per_cu = 0;
        hipGetDevice(&dev); hipDeviceGetAttribute(&cus, hipDeviceAttributeMultiprocessorCount, dev);
        hipFuncSetAttribute((const void*)mega, hipFuncAttributeMaxDynamicSharedMemorySize, LDS_BYTES);
        hipOccupancyMaxActiveBlocksPerMultiprocessor(&per_cu, (const void*)mega, NWAVES * 64, LDS_BYTES);
        (void)hipGetLastError();
        g_grid = (per_cu >= 1 && cus > 0) ? cus : 256;
        if (g_grid > 256) g_grid = 256;
    }
    Args a{};
    for (int i = 0; i < 34 && i < n_in; ++i) a.in[i] = (const float*)d_in[i];
    a.out = (float*)d_out; a.ws = (unsigned char*)d_ws;
    hipMemsetAsync((char*)d_ws + WS_CTL, 0, 1 * MiB, stream);
    const float* x = a.in[0]; (void)x;
    unsigned char* ws = (unsigned char*)d_ws; float* out = (float*)d_out;
    float* rope = (float*)(ws + WS_ROPE); float* s5ab = (float*)(ws + WS_S5AB); float* lam = (float*)(ws + WS_LAM); float* s5bb = (float*)(ws + WS_S5BB);
    bf16_t* Z = (bf16_t*)(ws + WS_Z); bf16_t* O = (bf16_t*)(ws + WS_O); bf16_t* U = (bf16_t*)(ws + WS_U); float* YT = (float*)(ws + WS_YT); bf16_t* G = (bf16_t*)(ws + WS_G);
    (void)out;
    launch_phases(a, 0, 1, stream);
    launch_phases(a, 1, 2, stream);
    launch_phases(a, 2, 3, stream);
#if !QKV_FUSE
    nv::qknorm_rope<<<dim3(M, 26), 64, 0, stream>>>(Z, a.in[12], a.in[13], a.in[15], a.in[16], rope);
#endif
    for (int p = 3; p <= 9; ++p) launch_phases(a, p, p + 1, stream);
    for (int p = 10; p <= 16; ++p) launch_phases(a, p, p + 1, stream);
}
```
